# Optimizing an MI355X kernel written in HIP

```python
import math
import jax, jax.numpy as jnp
from jax import lax
import numpy as np

D_MODEL = 1024
BATCH = 4
SEQ = 4096
DEPTH = 1

D_ATTN = 512
HEAD_DIM = 64
N_ATTN_HEADS = D_ATTN // HEAD_DIM
D_CONV = D_MODEL - D_ATTN
N_CONV_GROUPS = D_CONV // 64
CONV_WIDTH = 3
Q_BLOCK = 128
D_IN_PROJ = 3 * D_ATTN + 3 * D_CONV

N_GROUPS = 4
EXPERTS_PER_GROUP = 8
N_EXPERTS = N_GROUPS * EXPERTS_PER_GROUP
TOP_K_IN_GROUP = 2
D_EXPERT = 256

DEEPNORM_ALPHA = (2.0 * DEPTH) ** 0.25
DEEPNORM_BETA = (8.0 * DEPTH) ** -0.25
N_ADA = 6
LN_EPS = 1e-5

kernel_name = "hybrid_stickbreak_shortconv_hmoe_deepnorm_adaln"


def _layer_norm(x, g, b):
    xf = x.astype(jnp.float32)
    mu = jnp.mean(xf, axis=-1, keepdims=True)
    var = jnp.mean(jnp.square(xf - mu), axis=-1, keepdims=True)
    y = (xf - mu) * lax.rsqrt(var + LN_EPS)
    return (y * g.astype(jnp.float32) + b.astype(jnp.float32)).astype(x.dtype)


def _stick_breaking_attention(q, k, v):
    seq = q.shape[2]
    scale = HEAD_DIM ** -0.5
    outs = []
    for blk in range(seq // Q_BLOCK):
        start = blk * Q_BLOCK
        end = start + Q_BLOCK
        qb = q[:, :, start:end].astype(jnp.float32)
        kb = k[:, :, :end].astype(jnp.float32)
        vb = v[:, :, :end]
        z = jnp.einsum('bhqd,bhkd->bhqk', qb, kb) * scale
        t_pos = start + jnp.arange(Q_BLOCK)
        s_pos = jnp.arange(end)
        causal = s_pos[None, :] < t_pos[:, None]
        log_stay = jnp.where(causal, jax.nn.log_sigmoid(-z), 0.0)
        log_stay_after = lax.cumsum(log_stay, axis=3, reverse=True) - log_stay
        a = jnp.where(causal, jnp.exp(jax.nn.log_sigmoid(z) + log_stay_after), 0.0)
        outs.append(jnp.einsum('bhqk,bhkd->bhqd', a.astype(vb.dtype), vb))
    return jnp.concatenate(outs, axis=2)


def _causal_depthwise_conv(u, w):
    seq = u.shape[1]
    up = jnp.pad(u, ((0, 0), (CONV_WIDTH - 1, 0), (0, 0)))
    return sum(w[kk][None, None, :] * up[:, kk:kk + seq] for kk in range(CONV_WIDTH))


def _hierarchical_moe(h, w_rg, b_rg, w_re, b_re, w_gate, w_up, w_down):
    t = h.shape[0]
    hf = h.astype(jnp.float32)
    group_logits = hf @ w_rg.astype(jnp.float32) + b_rg.astype(jnp.float32)
    group_probs = jax.nn.softmax(group_logits, axis=-1)
    g_prob, g_idx = lax.top_k(group_probs, 1)
    exp_logits = (hf @ w_re.astype(jnp.float32) + b_re.astype(jnp.float32))
    exp_logits = exp_logits.reshape(t, N_GROUPS, EXPERTS_PER_GROUP)
    sel_logits = jnp.take_along_axis(exp_logits, g_idx[:, :, None], axis=1)[:, 0]
    sel_probs = jax.nn.softmax(sel_logits, axis=-1)
    top_p, top_i = lax.top_k(sel_probs, TOP_K_IN_GROUP)
    top_w = top_p / jnp.sum(top_p, axis=-1, keepdims=True) * g_prob
    in_group = jnp.sum(jax.nn.one_hot(top_i, EXPERTS_PER_GROUP, dtype=jnp.float32)
                       * top_w[:, :, None], axis=1)
    combine = jax.nn.one_hot(g_idx[:, 0], N_GROUPS, dtype=jnp.float32)[:, :, None] \
        * in_group[:, None, :]
    combine = combine.astype(h.dtype)
    w_gate = w_gate.reshape(N_GROUPS, EXPERTS_PER_GROUP, D_MODEL, D_EXPERT)
    w_up = w_up.reshape(N_GROUPS, EXPERTS_PER_GROUP, D_MODEL, D_EXPERT)
    w_down = w_down.reshape(N_GROUPS, EXPERTS_PER_GROUP, D_EXPERT, D_MODEL)
    y = jnp.zeros_like(h)
    for g in range(N_GROUPS):
        hid = jax.nn.silu(jnp.einsum('td,edf->tef', h, w_gate[g])) \
            * jnp.einsum('td,edf->tef', h, w_up[g])
        y = y + jnp.einsum('tef,te,efd->td', hid, combine[:, g], w_down[g])
    return y


def setup_inputs(seed: int = 0) -> dict:
    key = jax.random.key(seed)
    ks = jax.random.split(key, 20)
    f32 = jnp.float32
    d = D_MODEL
    x = jax.random.normal(ks[0], (BATCH, SEQ, d), f32)
    c = jax.random.normal(ks[1], (BATCH, d), f32)
    w_ada = jax.random.normal(ks[2], (DEPTH, d, N_ADA * d), f32) * (0.1 * d ** -0.5)
    ada_noise = 0.01 * jax.random.normal(ks[3], (DEPTH, N_ADA, d), f32)
    gate_bias = jnp.array([0.0, 0.0, 1.0, 0.0, 0.0, 1.0], f32)[None, :, None]
    b_ada = (ada_noise + gate_bias).reshape(DEPTH, N_ADA * d)
    w_in = jax.random.normal(ks[4], (DEPTH, d, D_IN_PROJ), f32) * d ** -0.5
    conv_w = jax.random.normal(ks[5], (DEPTH, CONV_WIDTH, D_CONV), f32) * CONV_WIDTH ** -0.5
    w_out = jax.random.normal(ks[6], (DEPTH, d, d), f32) * (d ** -0.5 * DEEPNORM_BETA)
    ln1_g = 1.0 + 0.01 * jax.random.normal(ks[7], (DEPTH, d), f32)
    ln1_b = 0.01 * jax.random.normal(ks[8], (DEPTH, d), f32)
    w_router_group = jax.random.normal(ks[9], (DEPTH, d, N_GROUPS), f32) * d ** -0.5
    b_router_group = 0.01 * jax.random.normal(ks[10], (DEPTH, N_GROUPS), f32)
    w_router_expert = jax.random.normal(ks[11], (DEPTH, d, N_EXPERTS), f32) * d ** -0.5
    b_router_expert = 0.01 * jax.random.normal(ks[12], (DEPTH, N_EXPERTS), f32)
    w_gate = jax.random.normal(ks[13], (DEPTH, N_EXPERTS, d, D_EXPERT), f32) * d ** -0.5
    w_up = jax.random.normal(ks[14], (DEPTH, N_EXPERTS, d, D_EXPERT), f32) * d ** -0.5
    w_down = jax.random.normal(ks[15], (DEPTH, N_EXPERTS, D_EXPERT, d), f32) \
        * (D_EXPERT ** -0.5 * DEEPNORM_BETA)
    ln2_g = 1.0 + 0.01 * jax.random.normal(ks[16], (DEPTH, d), f32)
    ln2_b = 0.01 * jax.random.normal(ks[17], (DEPTH, d), f32)
    return {"x": x, "c": c, "w_ada": w_ada, "b_ada": b_ada, "w_in": w_in,
            "conv_w": conv_w, "w_out": w_out, "ln1_g": ln1_g, "ln1_b": ln1_b,
            "w_router_group": w_router_group, "b_router_group": b_router_group,
            "w_router_expert": w_router_expert, "b_router_expert": b_router_expert,
            "w_gate": w_gate, "w_up": w_up, "w_down": w_down,
            "ln2_g": ln2_g, "ln2_b": ln2_b}


def reference(x, c, w_ada, b_ada, w_in, conv_w, w_out, ln1_g, ln1_b,
              w_router_group, b_router_group, w_router_expert, b_router_expert,
              w_gate, w_up, w_down, ln2_g, ln2_b):
    bsz, seq, d = x.shape
    for l in range(DEPTH):
        ada = (jax.nn.silu(c) @ w_ada[l] + b_ada[l]).reshape(bsz, N_ADA, d)
        shift1, scale1, gate1, shift2, scale2, gate2 = [ada[:, i][:, None, :] for i in range(N_ADA)]

        h = x * (1.0 + scale1) + shift1
        proj = h @ w_in[l]
        q, k, v, cb, cc, cx = jnp.split(
            proj, np.cumsum([D_ATTN, D_ATTN, D_ATTN, D_CONV, D_CONV]).tolist(), axis=-1)
        to_heads = lambda t: t.reshape(bsz, seq, N_ATTN_HEADS, HEAD_DIM).transpose(0, 2, 1, 3)
        attn = _stick_breaking_attention(to_heads(q), to_heads(k), to_heads(v))
        attn = attn.transpose(0, 2, 1, 3).reshape(bsz, seq, D_ATTN)
        conv = cb * _causal_depthwise_conv(cc * cx, conv_w[l])
        mix = jnp.concatenate([attn, conv], axis=-1) @ w_out[l]
        x = _layer_norm(DEEPNORM_ALPHA * x + gate1 * mix, ln1_g[l], ln1_b[l])

        h2 = (x * (1.0 + scale2) + shift2).reshape(bsz * seq, d)
        moe = _hierarchical_moe(h2, w_router_group[l], b_router_group[l],
                                w_router_expert[l], b_router_expert[l],
                                w_gate[l], w_up[l], w_down[l]).reshape(bsz, seq, d)
        x = _layer_norm(DEEPNORM_ALPHA * x + gate2 * moe, ln2_g[l], ln2_b[l])
    return x
```

```cpp
#include <hip/hip_runtime.h>
#include <cstdio>
#include <cstdint>
#ifndef MK_STAGE
#define MK_STAGE 4
#endif
namespace pg8 {
#define PG8_LAS __attribute__((address_space(3)))
typedef unsigned short bf16_t;
typedef short bf16x8 __attribute__((ext_vector_type(8)));
typedef float f32x4 __attribute__((ext_vector_type(4)));
typedef unsigned u32x4 __attribute__((ext_vector_type(4)));
constexpr int BM = 256, BK = 64, HALF = 128, HTB = HALF * BK * 2  , STAGE_BYTES = 8 * HTB, NXCD = 8, WGM = 8;

__host__ __device__ __forceinline__ int lds_byte(int r, int c) { const int st = (r >> 4) * 2 + (c >> 5), rr = r & 15, cc = c & 31, ob = rr * 64 + cc * 2; return st * 1024 + (ob ^ (((ob >> 9) & 1) << 5)); }
__host__ __device__ __forceinline__ void stage_rc(int b, int& R, int& C) { const int st = b / 1024, sb = b % 1024, swz = sb ^ (((sb >> 9) & 1) << 5); R = (st >> 1) * 16 + swz / 64; C = (st & 1) * 32 + (swz % 64) / 2; }
__host__ __device__ __forceinline__ int perm32(int rho) { const int n = rho >> 4, i = rho & 15; return 8 * (i >> 2) + 4 * n + (i & 3); }

struct Unit { int pm, pn; };
struct Gemm { const bf16_t* A; const bf16_t* Bt; int M, N, K; };

struct StaticOrder {
    int nM, nN, nwg, G, c;
    __host__ __device__ void init(int M, int N, int G_, int c_) { nM = M / BM; nN = N / BM; nwg = nM * nN; G = G_; c = c_; }
    __host__ __device__ bool next(int i, Unit& u) const {
        const long L = (long)i * G + c; if (L >= nwg) return false;
        int wgid = (int)L; { const int q = nwg / NXCD, r = nwg % NXCD, xcd = wgid % NXCD, off = wgid / NXCD; wgid = (xcd < r ? xcd * (q + 1) : r * (q + 1) + (xcd - r) * q) + off; }
        const int nig = WGM * nN, gid = wgid / nig, fm = gid * WGM, gsz = (nM - fm) < WGM ? (nM - fm) : WGM;
        u.pm = fm + ((wgid % nig) % gsz); u.pn = (wgid % nig) / gsz; return true;
    }
    __device__ __forceinline__ void a_ready(const Unit&) const {}
    __device__ __forceinline__ void done(const Unit&) const {}
};

__device__ __forceinline__ unsigned cvt_pk_bf16(float lo, float hi) { unsigned r; asm volatile("v_cvt_pk_bf16_f32 %0, %1, %2" : "=v"(r) : "v"(lo), "v"(hi)); return r; }
template <class Epi, class Sched, bool ALIGN_EPI = false, bool SP2 = false>
__device__ __forceinline__ void gemm_phase(PG8_LAS unsigned char* lds, const Gemm g, const Sched& S, const Epi& E) {
    const int tid = threadIdx.x, wid = __builtin_amdgcn_readfirstlane(tid >> 6), lane = tid & 63, wr = wid >> 2, wc = wid & 3, fr = lane & 15, fq = lane >> 4;
    const int K = g.K, nt = K / BK;
    unsigned voffA[2], voffB[2];
#pragma unroll
    for (int i = 0; i < 2; ++i) { int R, C; stage_rc(tid * 16 + i * 8192, R, C); const int Rb = Epi::PERM ? ((R & ~31) + perm32(R & 31)) : R;
        voffA[i] = (unsigned)(R * K + C) * 2u; voffB[i] = (unsigned)(Rb * K + C) * 2u; }
    const size_t kstep = (size_t)(BK * 2);
    const size_t hstep = (size_t)HALF * K * 2;
    const size_t tstep = 2 * hstep;
    const unsigned ldsw = (unsigned)wid * 1024u;
    const int aoff = lds_byte(wr * 64 + fr, fq * 8), boff = lds_byte(wc * 32 + fr, fq * 8);
#define PG8_SA(b, h) (((b) * 2 + (h)) * HTB)
#define PG8_SB(b, h) ((4 + (b) * 2 + (h)) * HTB)
#define PG8_STAGE(bufoff, gbase, voff) do { _Pragma("unroll") for (int _i = 0; _i < 2; ++_i) \
        __builtin_amdgcn_global_load_lds((const unsigned*)((const char*)(gbase) + (voff)[_i]), (PG8_LAS unsigned*)(lds + (bufoff) + ldsw + _i * 8192), 16, 0, 0); } while (0)
#define PG8_LDA(dst, b, h) do { _Pragma("unroll") for (int m = 0; m < 4; ++m) _Pragma("unroll") for (int k = 0; k < 2; ++k) dst[m][k] = *(const PG8_LAS bf16x8*)(lds + PG8_SA(b, h) + aoff + m * 2048 + k * 1024); } while (0)
#define PG8_LDB(dst, b, h) do { _Pragma("unroll") for (int n = 0; n < 2; ++n) _Pragma("unroll") for (int k = 0; k < 2; ++k) dst[n][k] = *(const PG8_LAS bf16x8*)(lds + PG8_SB(b, h) + boff + n * 2048 + k * 1024); } while (0)
#define PG8_MMA(ai, bj, At, Bt) do { __builtin_amdgcn_s_setprio(1); _Pragma("unroll") for (int m = 0; m < 4; ++m) _Pragma("unroll") for (int n = 0; n < 2; ++n) _Pragma("unroll") for (int k = 0; k < 2; ++k) \
        acc[ai][bj][m][n] = __builtin_amdgcn_mfma_f32_16x16x32_bf16(Bt[n][k], At[m][k], acc[ai][bj][m][n], 0, 0, 0); __builtin_amdgcn_s_setprio(0); } while (0)
#define PG8_WAIT_V(n) asm volatile("s_waitcnt vmcnt(" #n ")" ::: "memory")
#define PG8_WAIT_L(n) asm volatile("s_waitcnt lgkmcnt(" #n ")" ::: "memory")
#define PG8_BAR __builtin_amdgcn_s_barrier()
#define PG8_SCHED __builtin_amdgcn_sched_barrier(0)
    Unit cur, nxt; int ui = 0;
    if (!S.next(0, cur)) return;
    f32x4 acc[2][2][4][2];
#pragma unroll
    for (int a = 0; a < 2; ++a)
#pragma unroll
        for (int b = 0; b < 2; ++b)
#pragma unroll
            for (int m = 0; m < 4; ++m)
#pragma unroll
                for (int n = 0; n < 2; ++n) acc[a][b][m][n] = (f32x4){0.f, 0.f, 0.f, 0.f};
    bf16x8 At[4][2], B0[2][2], B1[2][2];
    const char* cA = (const char*)g.A + (size_t)cur.pm * tstep; const char* cB = (const char*)g.Bt + (size_t)cur.pn * tstep;
    S.a_ready(cur);
    if constexpr (SP2) {
        PG8_STAGE(PG8_SB(0, 0), cB, voffB); PG8_STAGE(PG8_SB(0, 1), cB + hstep, voffB); PG8_STAGE(PG8_SA(0, 0), cA, voffA); PG8_STAGE(PG8_SA(0, 1), cA + hstep, voffA);
        if (wr == 1) PG8_BAR;
        PG8_WAIT_V(2); PG8_BAR;
        PG8_STAGE(PG8_SB(1, 0), cB + kstep, voffB); PG8_STAGE(PG8_SA(1, 0), cA + kstep, voffA); PG8_STAGE(PG8_SB(1, 1), cB + hstep + kstep, voffB);
        PG8_WAIT_V(6); PG8_BAR;
    } else {
        PG8_STAGE(PG8_SB(0, 0), cB, voffB); PG8_STAGE(PG8_SA(0, 0), cA, voffA); PG8_STAGE(PG8_SB(0, 1), cB + hstep, voffB); PG8_STAGE(PG8_SA(0, 1), cA + hstep, voffA);
        if (wr == 1) PG8_BAR;
        PG8_WAIT_V(4); PG8_BAR;
        PG8_STAGE(PG8_SB(1, 0), cB + kstep, voffB); PG8_STAGE(PG8_SA(1, 0), cA + kstep, voffA); PG8_STAGE(PG8_SB(1, 1), cB + hstep + kstep, voffB);
        PG8_WAIT_V(6); PG8_BAR;
    }
    for (;;) {
        const bool has_next = S.next(ui + 1, nxt);
        const char* nA = has_next ? (const char*)g.A + (size_t)nxt.pm * tstep : cA; const char* nB = has_next ? (const char*)g.Bt + (size_t)nxt.pn * tstep : cB;
        for (int t = 0; t < nt; t += 2) {
            const bool last = (t == nt - 2);
            const char* a1 = cA + (size_t)(t + 1) * kstep;
            const char* a2 = last ? nA : cA + (size_t)(t + 2) * kstep; const char* b2 = last ? nB : cB + (size_t)(t + 2) * kstep;
            const char* a3 = a2 + kstep; const char* b3 = b2 + kstep;
            if (last && has_next) S.a_ready(nxt);
            if constexpr (SP2) {
            PG8_LDB(B0, 0, 0); PG8_LDB(B1, 0, 1); PG8_SCHED; PG8_LDA(At, 0, 0); PG8_STAGE(PG8_SA(1, 1), a1 + hstep, voffA);
            PG8_WAIT_V(8); PG8_WAIT_L(0); PG8_BAR; PG8_MMA(0, 0, At, B0); PG8_MMA(0, 1, At, B1); PG8_BAR; PG8_SCHED;
            PG8_LDA(At, 0, 1); PG8_STAGE(PG8_SB(0, 0), b2, voffB); PG8_STAGE(PG8_SB(0, 1), b2 + hstep, voffB); PG8_STAGE(PG8_SA(0, 0), a2, voffA);
            PG8_WAIT_V(8); PG8_WAIT_L(0); PG8_BAR; PG8_MMA(1, 0, At, B0); PG8_MMA(1, 1, At, B1); PG8_BAR; PG8_SCHED;
            PG8_LDB(B0, 1, 0); PG8_LDB(B1, 1, 1); PG8_SCHED; PG8_LDA(At, 1, 0); PG8_STAGE(PG8_SA(0, 1), a2 + hstep, voffA);
            PG8_WAIT_V(8); PG8_WAIT_L(0); PG8_BAR; PG8_MMA(0, 0, At, B0); PG8_MMA(0, 1, At, B1); PG8_BAR; PG8_SCHED;
            PG8_LDA(At, 1, 1); PG8_STAGE(PG8_SB(1, 0), b3, voffB); PG8_STAGE(PG8_SB(1, 1), b3 + hstep, voffB); PG8_STAGE(PG8_SA(1, 0), a3, voffA);
            PG8_WAIT_V(8); PG8_WAIT_L(0); PG8_BAR; PG8_MMA(1, 0, At, B0); PG8_MMA(1, 1, At, B1); PG8_BAR; PG8_SCHED;
            } else {
            PG8_LDB(B0, 0, 0); PG8_SCHED; PG8_LDA(At, 0, 0); PG8_STAGE(PG8_SA(1, 1), a1 + hstep, voffA);
            PG8_WAIT_L(8); PG8_BAR; PG8_WAIT_L(0); PG8_MMA(0, 0, At, B0); PG8_BAR; PG8_SCHED;
            PG8_LDB(B1, 0, 1); PG8_STAGE(PG8_SB(0, 0), b2, voffB);
            PG8_BAR; PG8_WAIT_L(0); PG8_MMA(0, 1, At, B1); PG8_BAR;
            PG8_LDA(At, 0, 1); PG8_STAGE(PG8_SA(0, 0), a2, voffA);
            PG8_BAR; PG8_WAIT_L(0); PG8_MMA(1, 0, At, B0); PG8_BAR; PG8_SCHED;
            PG8_STAGE(PG8_SB(0, 1), b2 + hstep, voffB);
            PG8_WAIT_V(6); PG8_BAR; PG8_MMA(1, 1, At, B1); PG8_BAR;
            PG8_LDB(B0, 1, 0); PG8_SCHED; PG8_LDA(At, 1, 0); PG8_STAGE(PG8_SA(0, 1), a2 + hstep, voffA);
            PG8_WAIT_L(8); PG8_BAR; PG8_WAIT_L(0); PG8_MMA(0, 0, At, B0); PG8_BAR; PG8_SCHED;
            PG8_LDB(B1, 1, 1); PG8_STAGE(PG8_SB(1, 0), b3, voffB);
            PG8_BAR; PG8_WAIT_L(0); PG8_MMA(0, 1, At, B1); PG8_BAR;
            PG8_LDA(At, 1, 1); PG8_STAGE(PG8_SA(1, 0), a3, voffA);
            PG8_BAR; PG8_WAIT_L(0); PG8_MMA(1, 0, At, B0); PG8_BAR; PG8_SCHED;
            PG8_STAGE(PG8_SB(1, 1), b3 + hstep, voffB);
            PG8_WAIT_V(6); PG8_BAR; PG8_MMA(1, 1, At, B1); PG8_BAR;
            }
        }
        if constexpr (ALIGN_EPI) { if (wr == 0) PG8_BAR; }
        if constexpr (!Epi::AFTER_DRAIN) { E(acc, cur, wr, wc, fr, fq); S.done(cur); }
        if (!has_next) break;
#pragma unroll
        for (int a = 0; a < 2; ++a)
#pragma unroll
            for (int b = 0; b < 2; ++b)
#pragma unroll
                for (int m = 0; m < 4; ++m)
#pragma unroll
                    for (int n = 0; n < 2; ++n) acc[a][b][m][n] = (f32x4){0.f, 0.f, 0.f, 0.f};
        cur = nxt; cA = nA; cB = nB; ++ui;
        if constexpr (ALIGN_EPI) { if (wr == 1) PG8_BAR; }
    }
    PG8_WAIT_V(0);
    if constexpr (!ALIGN_EPI) { if (wr == 0) PG8_BAR; }
    PG8_BAR;
    if constexpr (Epi::AFTER_DRAIN) { E.fused(acc, cur, wr, wc, fr, fq, lds, wid, lane); S.done(cur); }
#undef PG8_SA
#undef PG8_SB
#undef PG8_STAGE
#undef PG8_LDA
#undef PG8_LDB
#undef PG8_MMA
#undef PG8_WAIT_V
#undef PG8_WAIT_L
#undef PG8_BAR
#undef PG8_SCHED
}
}
namespace pg8 {
struct EpiProj {
    static constexpr bool PERM = true, AFTER_DRAIN = false;
    bf16_t* O; int ldc; int nq; float scale0;
    __device__ __forceinline__ void operator()(const f32x4 (&acc)[2][2][4][2], const Unit& u, int wr, int wc, int fr, int fq) const {
        const int row0 = u.pm * BM + wr * 64 + fr; const int col0 = u.pn * BM + wc * 32 + 8 * fq;
        const float sc = (u.pn < nq) ? scale0 : 1.f;
#pragma unroll
        for (int ai = 0; ai < 2; ++ai)
#pragma unroll
            for (int m = 0; m < 4; ++m) { bf16_t* rowp = O + (size_t)(row0 + ai * HALF + m * 16) * ldc + col0;
#pragma unroll
                for (int bj = 0; bj < 2; ++bj) { f32x4 v0 = acc[ai][bj][m][0] * sc, v1 = acc[ai][bj][m][1] * sc;
                    u32x4 w; w.x = cvt_pk_bf16(v0[0], v0[1]); w.y = cvt_pk_bf16(v0[2], v0[3]); w.z = cvt_pk_bf16(v1[0], v1[1]); w.w = cvt_pk_bf16(v1[2], v1[3]);
                    *(u32x4*)(rowp + bj * HALF) = w; } }
    }
};
}
constexpr int D = 1024, BATCH = 4, SEQ = 4096, T = BATCH * SEQ;
constexpr int DATT = 512, HD = 64, NH = 8, DCONV = 512, DPROJ = 3072;
constexpr int NG = 4, EPG = 8, NE = 32, DEXP = 256, NCOMBO = NG * 28;
constexpr float ALPHA = 1.189207115002721f;
constexpr float LN_EPS = 1e-5f;
constexpr float QSCALE = 0.125f * 1.4426950408889634f;
constexpr float P_STOP = 1e-30f;
constexpr int NWAVES = 8, NTHR = 512;
constexpr int LDS_BYTES = 163840;

constexpr size_t MiB = 1u << 20;
constexpr size_t WS_CTL = 0, CTL_ZERO_BYTES = 64 * 1024;
constexpr size_t WS_ADA = 1 * MiB;
constexpr size_t WS_RC = 2 * MiB;
constexpr size_t WS_RW = 2 * MiB + 256 * 1024;
constexpr size_t WS_RE = 2 * MiB + 512 * 1024;
constexpr size_t WS_WR = 3 * MiB;
constexpr size_t WS_WOUT = 4 * MiB;
constexpr size_t WS_WIN = 6 * MiB;
constexpr size_t WS_WGU = 12 * MiB;
constexpr size_t WS_WD = 44 * MiB;
constexpr size_t WS_HX = 64 * MiB;
constexpr size_t WS_PROJ = 96 * MiB;
constexpr size_t WS_H2 = 192 * MiB;
constexpr size_t WS_END = 224 * MiB;
constexpr int CW_ADACNT = 64;
constexpr int CW_BAR = 1024;

#define GAS __attribute__((address_space(1)))
#define LAS __attribute__((address_space(3)))
typedef unsigned short bf16;
typedef unsigned v4u __attribute__((ext_vector_type(4)));
typedef unsigned v2u __attribute__((ext_vector_type(2)));
typedef float f32x4 __attribute__((ext_vector_type(4)));
typedef float f32x2 __attribute__((ext_vector_type(2)));
typedef float f32x16 __attribute__((ext_vector_type(16)));
typedef short bf16x8 __attribute__((ext_vector_type(8)));
typedef short s16x4 __attribute__((ext_vector_type(4)));
typedef GAS unsigned gu32;
#define RLX_AGENT __ATOMIC_RELAXED, __HIP_MEMORY_SCOPE_AGENT
#define LDS_WAIT() asm volatile("s_waitcnt lgkmcnt(0)" ::: "memory")
#define VM_WAIT() asm volatile("s_waitcnt vmcnt(0)" ::: "memory")
typedef __bf16 bf16x2_t __attribute__((ext_vector_type(2)));
__device__ __forceinline__ unsigned pk2(float lo, float hi) { f32x2 v = {lo, hi}; bf16x2_t b = __builtin_convertvector(v, bf16x2_t); return __builtin_bit_cast(unsigned, b); }
__device__ __forceinline__ float bf2f(unsigned short u) { return __builtin_bit_cast(float, (unsigned)u << 16); }
__device__ __forceinline__ float bflo(unsigned u) { return __builtin_bit_cast(float, u << 16); }
__device__ __forceinline__ float bfhi(unsigned u) { return __builtin_bit_cast(float, u & 0xffff0000u); }
__device__ __forceinline__ int lane_now() { int l = (int)__builtin_amdgcn_mbcnt_hi(~0u, __builtin_amdgcn_mbcnt_lo(~0u, 0u)); asm volatile("" : "+v"(l)); return l; }
__device__ __forceinline__ float shx(float v, int m, int lane) { return __builtin_bit_cast(float, __builtin_amdgcn_ds_bpermute((lane ^ m) << 2, __builtin_bit_cast(int, v))); }
#define XB_TMO      128
#define XB_XCNT(j)  (256  + 64 * (j))
#define XB_XSUB(j)  (1280 + 64 * (j))
#define XB_XGEN(j)  (2304 + 64 * (j))
#define XB_TOP      3328
#define XB_TOPGEN   3392
#define XCD_BAR_WORDS 3456
#define XB_SPIN_CAP (1u << 18)

__device__ __forceinline__ unsigned xb_ld(unsigned* p)              { return __hip_atomic_load(p, __ATOMIC_RELAXED, __HIP_MEMORY_SCOPE_AGENT); }
__device__ __forceinline__ unsigned xb_add(unsigned* p, unsigned v) { return __hip_atomic_fetch_add(p, v, __ATOMIC_RELAXED, __HIP_MEMORY_SCOPE_AGENT); }
__device__ __forceinline__ unsigned xb_xcc_id() { return (unsigned)__builtin_amdgcn_s_getreg((3 << 11) | 20) & 0xFu; }
#define XB_SPIN(cond, bar) do { unsigned _sp = 0; while (cond) { __builtin_amdgcn_s_sleep(1); \
    if ((++_sp & 255u) == 0u) { if (xb_ld(&(bar)[XB_TMO])) break; if (_sp > XB_SPIN_CAP) { atomicAdd(&(bar)[XB_TMO], 1u); break; } } } } while (0)

struct XcdBarrier {
    unsigned* bar; unsigned x;
    volatile LAS unsigned* st;
};

__device__ __forceinline__ XcdBarrier xcd_barrier_post(unsigned* bar, volatile LAS unsigned* st) {
    XcdBarrier b; b.bar = bar; b.x = xb_xcc_id(); b.st = st;
    if (threadIdx.x == 0) (void)xb_add(&bar[XB_XCNT(b.x)], 1u);
    return b;
}
__device__ __forceinline__ void xcd_barrier_complete(unsigned* bar, unsigned x, unsigned& nloc, unsigned& nx) {
    const unsigned G = gridDim.x * gridDim.y * gridDim.z;
    unsigned sum, cnt, mine, sp = 0u;
    for (;;) {
        sum = 0u; cnt = 0u; mine = 0u;
#pragma unroll
        for (unsigned j = 0; j < 16; ++j) { const unsigned c = xb_ld(&bar[XB_XCNT(j)]); sum += c; cnt += (c > 0u) ? 1u : 0u; mine = (j == x) ? c : mine; }
        if (sum == G) break;
        __builtin_amdgcn_s_sleep(1);
        if ((++sp & 255u) == 0u) { if (xb_ld(&bar[XB_TMO])) break; if (sp > XB_SPIN_CAP) { atomicAdd(&bar[XB_TMO], 1u); break; } }
    }
    nloc = mine > 0u ? mine : 1u; nx = cnt > 0u ? cnt : 1u;
}

__device__ __forceinline__ void xcd_barrier(const XcdBarrier& b) {
    asm volatile("s_waitcnt vmcnt(0)" ::: "memory");
    __syncthreads();
    if (threadIdx.x == 0) {
        unsigned* bar = b.bar;
        __builtin_amdgcn_s_waitcnt(0);
        unsigned nloc = b.st[0], nx = b.st[1];
        if (nloc == 0u) { xcd_barrier_complete(bar, b.x, nloc, nx); b.st[0] = nloc; b.st[1] = nx; }
        const unsigned old = xb_add(&bar[XB_XSUB(b.x)], 1u);
        const unsigned gen = old / nloc;
        if (old + 1u == (gen + 1u) * nloc) {
            __builtin_amdgcn_fence(__ATOMIC_RELEASE, "agent");
            asm volatile("s_waitcnt vmcnt(0)" ::: "memory");
            const unsigned og = xb_add(&bar[XB_TOP], 1u);
            const unsigned tg = og / nx;
            if (og + 1u == (tg + 1u) * nx) xb_add(&bar[XB_TOPGEN], 1u);
            else XB_SPIN(xb_ld(&bar[XB_TOPGEN]) == tg, bar);
            __builtin_amdgcn_fence(__ATOMIC_ACQUIRE, "agent");
            xb_add(&bar[XB_XGEN(b.x)], 1u);
            asm volatile("s_waitcnt vmcnt(0)" ::: "memory");
        } else {
            XB_SPIN(xb_ld(&bar[XB_XGEN(b.x)]) == gen, bar);
            __builtin_amdgcn_fence(__ATOMIC_ACQUIRE, "agent");
            asm volatile("s_waitcnt vmcnt(0)" ::: "memory");
        }
    }
    __syncthreads();
}
struct Frame {
    LAS unsigned char* lds;
    int tid, lane, wave, vcu, G;
    const float *x, *c, *w_ada, *b_ada, *w_in, *conv_w, *w_out, *ln1_g, *ln1_b, *wrg, *brg, *wre, *bre, *wg, *wu, *wd, *ln2_g, *ln2_b;
    float* out; unsigned char* ws; gu32* ctl;
};

__device__ __forceinline__ void p0_ada_item(Frame& F, int item) {
    LAS float* sc = (LAS float*)F.lds;
    LAS float* red = (LAS float*)(F.lds + 16384);
    for (int i = F.tid; i < 4 * D; i += NTHR) { const float cv = F.c[i]; sc[i] = cv / (1.f + expf(-cv)); }
    __syncthreads();
    const int n0 = 256 * item, k0 = 128 * F.wave;
    f32x4 acc[4];
#pragma unroll
    for (int b = 0; b < 4; ++b) acc[b] = (f32x4){0.f, 0.f, 0.f, 0.f};
    const float* wp = F.w_ada + (size_t)k0 * (6 * D) + n0 + 4 * F.lane;
#pragma unroll 8
    for (int k = 0; k < 128; ++k) { const f32x4 wv = *(const f32x4*)(wp + (size_t)k * (6 * D));
#pragma unroll
        for (int b = 0; b < 4; ++b) acc[b] += sc[b * D + k0 + k] * wv; }
#pragma unroll
    for (int b = 0; b < 4; ++b) *(LAS f32x4*)(red + (F.wave * 4 + b) * 256 + 4 * F.lane) = acc[b];
    __syncthreads();
    float* ada = (float*)(F.ws + WS_ADA);
    for (int o = F.tid; o < 1024; o += NTHR) { const int b = o >> 8, n = o & 255; float s = 0.f;
#pragma unroll
        for (int w = 0; w < 8; ++w) s += red[(w * 4 + b) * 256 + n];
        ada[b * 6 * D + n0 + n] = s + F.b_ada[n0 + n]; }
    __syncthreads();
}
__device__ __forceinline__ void p0_transpose_item(const float* W, int K, int N, bf16* WT, LAS float* scr, int item, int lane) {
    const int nblk = N / 32, kb = item / nblk, nb = item % nblk, k0 = 64 * kb, n0 = 32 * nb;
#pragma unroll 8
    for (int i = 0; i < 32; ++i) { const int kk = 2 * i + (lane >> 5); scr[kk * 33 + (lane & 31)] = W[(size_t)(k0 + kk) * N + n0 + (lane & 31)]; }
    LDS_WAIT(); asm volatile("" ::: "memory");
    const int c = lane & 7;
#pragma unroll
    for (int j = 0; j < 4; ++j) { const int n = (lane >> 3) + 8 * j; const LAS float* s = scr + (8 * c) * 33 + n;
        v4u o; o.x = pk2(s[0 * 33], s[1 * 33]); o.y = pk2(s[2 * 33], s[3 * 33]); o.z = pk2(s[4 * 33], s[5 * 33]); o.w = pk2(s[6 * 33], s[7 * 33]);
        *(GAS v4u*)(WT + (size_t)(n0 + n) * K + k0 + 8 * c) = o; }
    LDS_WAIT(); asm volatile("" ::: "memory");
}
__device__ __forceinline__ void p0_shuf_item(const float* W, int ldw, int k0, int n0, bf16* dst, int strideA, LAS float* scr, int lane) {
#pragma unroll 8
    for (int r = 0; r < 32; ++r) { const f32x2 v = *(const f32x2*)(W + (size_t)(k0 + r) * ldw + n0 + 2 * lane); *(LAS f32x2*)(scr + r * 130 + 2 * lane) = v; }
    LDS_WAIT(); asm volatile("" ::: "memory");
    const LAS float* s0 = scr + (8 * (lane >> 4)) * 130 + (lane & 15);
#pragma unroll
    for (int nt = 0; nt < 8; ++nt) { const LAS float* s = s0 + 16 * nt;
        v4u o; o.x = pk2(s[0 * 130], s[1 * 130]); o.y = pk2(s[2 * 130], s[3 * 130]); o.z = pk2(s[4 * 130], s[5 * 130]); o.w = pk2(s[6 * 130], s[7 * 130]);
        *(GAS v4u*)(dst + (size_t)(nt >> 1) * strideA + (nt & 1) * 512 + lane * 8) = o; }
    LDS_WAIT(); asm volatile("" ::: "memory");
}
__device__ __forceinline__ void p0_router_item(Frame& F, int ks) {
    bf16* WR = (bf16*)(F.ws + WS_WR); const int lane = F.lane;
#pragma unroll
    for (int nt = 0; nt < 3; ++nt) { const int col = 16 * nt + (lane & 15); float f[8];
#pragma unroll
        for (int j = 0; j < 8; ++j) { const int k = 32 * ks + 8 * (lane >> 4) + j; f[j] = col < NG ? F.wrg[k * NG + col] : (col < NG + NE ? F.wre[k * NE + (col - NG)] : 0.f); }
        v4u o; o.x = pk2(f[0], f[1]); o.y = pk2(f[2], f[3]); o.z = pk2(f[4], f[5]); o.w = pk2(f[6], f[7]);
        *(GAS v4u*)(WR + ((size_t)(ks * 3 + nt) * 64 + lane) * 8) = o; }
}
__device__ __forceinline__ void p0_prologue(Frame& F) {
    constexpr int N_ADA_ITEMS = 6 * D / 256;
    if (F.vcu < N_ADA_ITEMS) {
        p0_ada_item(F, F.vcu);
        VM_WAIT(); __syncthreads();
        if (F.tid == 0) { __builtin_amdgcn_fence(__ATOMIC_RELEASE, "agent"); VM_WAIT(); __hip_atomic_fetch_add(F.ctl + CW_ADACNT, 1u, RLX_AGENT); }
    }
    LAS float* scr = (LAS float*)(F.lds + F.wave * 16640);
    const int gw = F.vcu * NWAVES + F.wave, NGW = F.G * NWAVES;
    constexpr int I_WIN = (D / 64) * (DPROJ / 32), I_WOUT = 32 * 8, I_G = NE * 32 * 2, I_U = I_G, I_D = NE * 8 * 8, I_R = 32;
    constexpr int NITEMS = I_WIN + I_WOUT + I_G + I_U + I_D + I_R;
    for (int it = gw; it < NITEMS; it += NGW) {
        int r = it;
        if (r < I_WIN) { p0_transpose_item(F.w_in, D, DPROJ, (bf16*)(F.ws + WS_WIN), scr, r, F.lane); continue; } r -= I_WIN;
        if (r < I_WOUT) { const int ks = r >> 3, cb = r & 7; p0_shuf_item(F.w_out, D, 32 * ks, 128 * cb, (bf16*)(F.ws + WS_WOUT) + ((size_t)(cb * 32 + ks) * 8) * 512, 1024, scr, F.lane); continue; } r -= I_WOUT;
        if (r < I_G + I_U) { const int which = r >= I_G ? 1 : 0; if (which) r -= I_G; const int e = r >> 6, ks = (r >> 1) & 31, half = r & 1;
            const float* W = (which ? F.wu : F.wg) + (size_t)e * D * DEXP;
            p0_shuf_item(W, DEXP, 32 * ks, 128 * half, (bf16*)(F.ws + WS_WGU) + ((((size_t)(e * 8 + 4 * half) * 32 + ks) * 4 + which * 2) * 512), 32 * 4 * 512, scr, F.lane); continue; } r -= I_G + I_U;
        if (r < I_D) { const int e = r >> 6, ks = (r >> 3) & 7, cb = r & 7;
            p0_shuf_item(F.wd + (size_t)e * DEXP * D, D, 32 * ks, 128 * cb, (bf16*)(F.ws + WS_WD) + (((size_t)(e * 8 + cb) * 8 + ks) * 8) * 512, 1024, scr, F.lane); continue; } r -= I_D;
        p0_router_item(F, r);
    }
    if (F.tid == 0) { unsigned sp = 0; while (__hip_atomic_load(F.ctl + CW_ADACNT, RLX_AGENT) < (unsigned)N_ADA_ITEMS) { __builtin_amdgcn_s_sleep(2); if (++sp > (1u << 22)) break; }
        __builtin_amdgcn_fence(__ATOMIC_ACQUIRE, "agent"); VM_WAIT(); }
    __syncthreads();
    const float* ada = (const float*)(F.ws + WS_ADA); bf16* HX = (bf16*)(F.ws + WS_HX);
    for (int m = gw; m < T; m += NGW) { const int b = m / SEQ;
        const f32x4* xr = (const f32x4*)(F.x + (size_t)m * D) + F.lane; const f32x4* sc = (const f32x4*)(ada + b * 6 * D + 1 * D) + F.lane; const f32x4* sh = (const f32x4*)(ada + b * 6 * D) + F.lane;
        unsigned long long* o8 = (unsigned long long*)(HX + (size_t)m * D) + F.lane;
#pragma unroll
        for (int j = 0; j < 4; ++j) { const f32x4 v = xr[64 * j], s = sc[64 * j], t = sh[64 * j]; const f32x4 h = v * (1.f + s) + t;
            o8[64 * j] = (unsigned long long)pk2(h.x, h.y) | ((unsigned long long)pk2(h.z, h.w) << 32); }
    }
}
constexpr int A_STRIDE = 1040;
constexpr int P3_AATT = 0, P3_ACONV = 64 * A_STRIDE;
constexpr int H_STRIDE = 2064;
constexpr int P3_LG = 2 * 64 * A_STRIDE;
constexpr int P3_RED = P3_LG + 24576;
constexpr int P3_END = P3_RED + 4096;
static_assert(P3_END + 256 <= LDS_BYTES && 64 * H_STRIDE <= P3_LG, "P3 LDS map");
constexpr int MISC_OFF = LDS_BYTES - 256;

__device__ __forceinline__ int crow(int r, int hi) { return (r & 3) + 8 * (r >> 2) + 4 * hi; }

__device__ __forceinline__ void sb_scan(f32x16& x, float& P, bool diag, int keybase, int t, int hi, int lane) {
    float r[16], s[16], Tg[4], U[4];
#pragma unroll
    for (int i = 0; i < 16; ++i) { const float e = __builtin_amdgcn_exp2f(x[i]); r[i] = __builtin_amdgcn_rcpf(1.f + e); }
    if (diag) {
#pragma unroll
        for (int i = 0; i < 16; ++i) { const int key = keybase + crow(i, hi); r[i] = key >= t ? 1.f : r[i]; }
    }
#pragma unroll
    for (int g = 0; g < 4; ++g) { const int b = 4 * g; s[b + 3] = 1.f; s[b + 2] = r[b + 3]; s[b + 1] = s[b + 2] * r[b + 2]; s[b] = s[b + 1] * r[b + 1]; Tg[g] = s[b] * r[b]; }
#pragma unroll
    for (int g = 0; g < 4; ++g) U[g] = shx(Tg[g], 32, lane);
    const float W0 = Tg[0] * U[0], W1 = Tg[1] * U[1], W2 = Tg[2] * U[2], W3 = Tg[3] * U[3];
    float S[4]; S[3] = 1.f; S[2] = W3; S[1] = W3 * W2; S[0] = S[1] * W1;
    const float tot = S[0] * W0;
    float Fg[4];
#pragma unroll
    for (int g = 0; g < 4; ++g) Fg[g] = S[g] * (hi ? 1.f : U[g]) * P;
#pragma unroll
    for (int i = 0; i < 16; ++i) x[i] = (1.f - r[i]) * (s[i] * Fg[i >> 2]);
    P *= tot;
}
__device__ __forceinline__ void pv64(f32x16& o0, f32x16& o1, int vb, bf16x8 pa0, bf16x8 pa1, bf16x8 pa2, bf16x8 pa3) {
#define PK(k) (bf16x8){lo[k][0], lo[k][1], lo[k][2], lo[k][3], hi[k][0], hi[k][1], hi[k][2], hi[k][3]}
    { s16x4 lo[4], hi[4];
#pragma unroll
      for (int ks = 0; ks < 4; ++ks) {
          asm volatile("ds_read_b64_tr_b16 %0,%1 offset:%c2" : "=&v"(lo[ks]) : "v"(vb), "i"(ks * 1024) : "memory");
          asm volatile("ds_read_b64_tr_b16 %0,%1 offset:%c2" : "=&v"(hi[ks]) : "v"(vb), "i"(ks * 1024 + 512) : "memory"); }
      asm volatile("s_waitcnt lgkmcnt(0)" ::: "memory"); __builtin_amdgcn_sched_barrier(0);
      o0 = __builtin_amdgcn_mfma_f32_32x32x16_bf16(pa0, PK(0), o0, 0, 0, 0); o0 = __builtin_amdgcn_mfma_f32_32x32x16_bf16(pa1, PK(1), o0, 0, 0, 0);
      o0 = __builtin_amdgcn_mfma_f32_32x32x16_bf16(pa2, PK(2), o0, 0, 0, 0); o0 = __builtin_amdgcn_mfma_f32_32x32x16_bf16(pa3, PK(3), o0, 0, 0, 0); }
    { s16x4 lo[4], hi[4];
#pragma unroll
      for (int ks = 0; ks < 4; ++ks) {
          asm volatile("ds_read_b64_tr_b16 %0,%1 offset:%c2" : "=&v"(lo[ks]) : "v"(vb), "i"(4096 + ks * 1024) : "memory");
          asm volatile("ds_read_b64_tr_b16 %0,%1 offset:%c2" : "=&v"(hi[ks]) : "v"(vb), "i"(4096 + ks * 1024 + 512) : "memory"); }
      asm volatile("s_waitcnt lgkmcnt(0)" ::: "memory"); __builtin_amdgcn_sched_barrier(0);
      o1 = __builtin_amdgcn_mfma_f32_32x32x16_bf16(pa0, PK(0), o1, 0, 0, 0); o1 = __builtin_amdgcn_mfma_f32_32x32x16_bf16(pa1, PK(1), o1, 0, 0, 0);
      o1 = __builtin_amdgcn_mfma_f32_32x32x16_bf16(pa2, PK(2), o1, 0, 0, 0); o1 = __builtin_amdgcn_mfma_f32_32x32x16_bf16(pa3, PK(3), o1, 0, 0, 0); }
#undef PK
}
__device__ __forceinline__ void attn_unit(const bf16* PROJ, int b, int h, int q0, LAS unsigned char* vst, LAS unsigned char* aatt, int arow0, int lane) {
    const int r32 = lane & 31, hi = lane >> 5;
    const size_t rowb = (size_t)b * SEQ;
    bf16x8 qr[4];
    { const bf16* qp = PROJ + (rowb + q0 + r32) * DPROJ + h * HD + hi * 8;
#pragma unroll
      for (int ks = 0; ks < 4; ++ks) qr[ks] = *(const bf16x8*)(qp + ks * 16); }
    f32x16 o0, o1;
#pragma unroll
    for (int i = 0; i < 16; ++i) { o0[i] = 0.f; o1[i] = 0.f; }
    float P = 1.f;
    const int t = q0 + r32;
    const int vb = (int)(unsigned)(uintptr_t)vst + ((lane >> 4) & 1) * 32 + (lane & 3) * 8 + (4 * hi + ((lane & 15) >> 2)) * 64;
    for (int jb = (q0 + 31) >> 6; jb >= 0; --jb) {
        const int kb0 = jb * 64;
        bf16x8 k0[4], k1[4];
        { const bf16* kp = PROJ + (rowb + kb0 + r32) * DPROJ + DATT + h * HD + hi * 8;
#pragma unroll
          for (int ks = 0; ks < 4; ++ks) { k0[ks] = *(const bf16x8*)(kp + ks * 16); k1[ks] = *(const bf16x8*)(kp + (size_t)32 * DPROJ + ks * 16); } }
        v4u vv[8];
#pragma unroll
        for (int i = 0; i < 8; ++i) { const int p = i * 64 + lane, key = p >> 3, c = p & 7; vv[i] = *(const v4u*)(PROJ + (rowb + kb0 + key) * DPROJ + 2 * DATT + h * HD + c * 8); }
#pragma unroll
        for (int i = 0; i < 8; ++i) { const int p = i * 64 + lane, key = p >> 3, c = p & 7; *(LAS v4u*)(vst + (c >> 2) * 4096 + key * 64 + (c & 3) * 16) = vv[i]; }
        f32x16 p0, p1;
#pragma unroll
        for (int i = 0; i < 16; ++i) { p0[i] = 0.f; p1[i] = 0.f; }
#pragma unroll
        for (int ks = 0; ks < 4; ++ks) { p0 = __builtin_amdgcn_mfma_f32_32x32x16_bf16(k0[ks], qr[ks], p0, 0, 0, 0); p1 = __builtin_amdgcn_mfma_f32_32x32x16_bf16(k1[ks], qr[ks], p1, 0, 0, 0); }
        const bool diag = (kb0 + 63 >= q0);
        sb_scan(p1, P, diag, kb0 + 32, t, hi, lane);
        sb_scan(p0, P, diag, kb0, t, hi, lane);
        v4u pw0, pw1, pw2, pw3;
        pw0 = (v4u){pk2(p0[0], p0[1]), pk2(p0[2], p0[3]), pk2(p0[4], p0[5]), pk2(p0[6], p0[7])};
        pw1 = (v4u){pk2(p0[8], p0[9]), pk2(p0[10], p0[11]), pk2(p0[12], p0[13]), pk2(p0[14], p0[15])};
        pw2 = (v4u){pk2(p1[0], p1[1]), pk2(p1[2], p1[3]), pk2(p1[4], p1[5]), pk2(p1[6], p1[7])};
        pw3 = (v4u){pk2(p1[8], p1[9]), pk2(p1[10], p1[11]), pk2(p1[12], p1[13]), pk2(p1[14], p1[15])};
        LDS_WAIT();
        pv64(o0, o1, vb, __builtin_bit_cast(bf16x8, pw0), __builtin_bit_cast(bf16x8, pw1), __builtin_bit_cast(bf16x8, pw2), __builtin_bit_cast(bf16x8, pw3));
        if (__all(P < P_STOP)) break;
    }
#pragma unroll
    for (int r = 0; r < 16; ++r) { LAS unsigned short* dst = (LAS unsigned short*)(aatt + (arow0 + crow(r, hi)) * A_STRIDE + (h * HD + r32) * 2);
        dst[0] = (unsigned short)(pk2(o0[r], 0.f) & 0xffffu); dst[32] = (unsigned short)(pk2(o1[r], 0.f) & 0xffffu); }
}
__device__ __forceinline__ void row_stats(const f32x4 (&v)[4][8], LAS float* red, int w, int lane, float (&mean)[4], float (&rstd)[4]) {
    const int fr = lane & 15, fq = lane >> 4;
#pragma unroll
    for (int mt = 0; mt < 4; ++mt) { float s = 0.f;
#pragma unroll
        for (int nt = 0; nt < 8; ++nt) s += (v[mt][nt][0] + v[mt][nt][1]) + (v[mt][nt][2] + v[mt][nt][3]);
        s += shx(s, 16, lane); s += shx(s, 32, lane);
        if (fq == 0) red[w * 64 + 16 * mt + fr] = s; }
    __syncthreads();
#pragma unroll
    for (int mt = 0; mt < 4; ++mt) { float s = 0.f;
#pragma unroll
        for (int ww = 0; ww < 8; ++ww) s += red[ww * 64 + 16 * mt + fr];
        mean[mt] = s * (1.f / D); }
#pragma unroll
    for (int mt = 0; mt < 4; ++mt) { float q = 0.f;
#pragma unroll
        for (int nt = 0; nt < 8; ++nt) { const f32x4 d = v[mt][nt] - mean[mt]; q += (d[0] * d[0] + d[1] * d[1]) + (d[2] * d[2] + d[3] * d[3]); }
        q += shx(q, 16, lane); q += shx(q, 32, lane);
        if (fq == 0) red[512 + w * 64 + 16 * mt + fr] = q; }
    __syncthreads();
#pragma unroll
    for (int mt = 0; mt < 4; ++mt) { float q = 0.f;
#pragma unroll
        for (int ww = 0; ww < 8; ++ww) q += red[512 + ww * 64 + 16 * mt + fr];
        rstd[mt] = 1.f / sqrtf(q * (1.f / D) + LN_EPS); }
}

template <int NKS>
__device__ __forceinline__ void panel_gemm8(f32x4 (&acc)[4][8], const LAS unsigned char* a0  , int astride, const unsigned char* bp  ) {
    bf16x8 Bc[8], Af[4];
#pragma unroll
    for (int nt = 0; nt < 8; ++nt) Bc[nt] = *(const bf16x8*)(bp + nt * 1024);
#pragma unroll 1
    for (int ks = 0; ks < NKS; ++ks) {
        const unsigned char* bn = bp + (size_t)(ks + 1 < NKS ? ks + 1 : ks) * 8192;
#pragma unroll
        for (int mt = 0; mt < 4; ++mt) Af[mt] = *(const LAS bf16x8*)(a0 + mt * 16 * astride + ks * 64);
#pragma unroll
        for (int nt = 0; nt < 8; ++nt) {
#pragma unroll
            for (int mt = 0; mt < 4; ++mt) acc[mt][nt] = __builtin_amdgcn_mfma_f32_16x16x32_bf16(Bc[nt], Af[mt], acc[mt][nt], 0, 0, 0);
            Bc[nt] = *(const bf16x8*)(bn + nt * 1024);
        }
    }
}

__device__ __forceinline__ void p3_panel(Frame& F, int tile) {
    const int m0 = tile * 64, b = m0 / SEQ, t0 = m0 % SEQ;
    const int w = F.wave;
    const bf16* PROJ = (const bf16*)(F.ws + WS_PROJ);
    const float* ada = (const float*)(F.ws + WS_ADA) + b * 6 * D;
    LAS unsigned char* lds = F.lds;
    attn_unit(PROJ, b, w, t0, lds + P3_ACONV + w * 8192, lds + P3_AATT, 0, lane_now());
    attn_unit(PROJ, b, w, t0 + 32, lds + P3_ACONV + w * 8192, lds + P3_AATT, 32, lane_now());
    LDS_WAIT(); __syncthreads();
    { const int tid = w * 64 + lane_now();
#pragma unroll 1
    for (int i = 0; i < 8; ++i) { const int p = i * NTHR + tid, row = p >> 6, ch = p & 63, t = t0 + row;
        const bf16* base = PROJ + (size_t)(m0 + row) * DPROJ + 8 * ch;
        const v4u cb = *(const v4u*)(base + 1536);
        float y[8];
#pragma unroll
        for (int j = 0; j < 8; ++j) y[j] = 0.f;
#pragma unroll
        for (int kk = 0; kk < 3; ++kk) { if (t - 2 + kk >= 0) { const bf16* rp = base - (size_t)(2 - kk) * DPROJ; const v4u cc = *(const v4u*)(rp + 2048), cx = *(const v4u*)(rp + 2560);
                const f32x4 w0 = *(const f32x4*)(F.conv_w + kk * DCONV + 8 * ch), w1 = *(const f32x4*)(F.conv_w + kk * DCONV + 8 * ch + 4);
                y[0] += w0[0] * bflo(cc.x) * bflo(cx.x); y[1] += w0[1] * bfhi(cc.x) * bfhi(cx.x); y[2] += w0[2] * bflo(cc.y) * bflo(cx.y); y[3] += w0[3] * bfhi(cc.y) * bfhi(cx.y);
                y[4] += w1[0] * bflo(cc.z) * bflo(cx.z); y[5] += w1[1] * bfhi(cc.z) * bfhi(cx.z); y[6] += w1[2] * bflo(cc.w) * bflo(cx.w); y[7] += w1[3] * bfhi(cc.w) * bfhi(cx.w); } }
        v4u o; o.x = pk2(bflo(cb.x) * y[0], bfhi(cb.x) * y[1]); o.y = pk2(bflo(cb.y) * y[2], bfhi(cb.y) * y[3]); o.z = pk2(bflo(cb.z) * y[4], bfhi(cb.z) * y[5]); o.w = pk2(bflo(cb.w) * y[6], bfhi(cb.w) * y[7]);
        *(LAS v4u*)(lds + P3_ACONV + row * A_STRIDE + ch * 16) = o; } }
    LDS_WAIT(); __syncthreads();
    const int lane = lane_now(), fr = lane & 15, fq = lane >> 4;
    f32x4 acc[4][8];
#pragma unroll
    for (int mt = 0; mt < 4; ++mt)
#pragma unroll
        for (int nt = 0; nt < 8; ++nt) acc[mt][nt] = (f32x4){0.f, 0.f, 0.f, 0.f};
    const unsigned char* bp = F.ws + WS_WOUT + (size_t)w * 32 * 8192 + lane * 16;
    panel_gemm8<16>(acc, lds + P3_AATT + fr * A_STRIDE + fq * 16, A_STRIDE, bp);
    panel_gemm8<16>(acc, lds + P3_ACONV + fr * A_STRIDE + fq * 16, A_STRIDE, bp + 16 * 8192);
    const int colw = 128 * w + 4 * fq;
#pragma unroll
    for (int nt = 0; nt < 8; ++nt) { const f32x4 g1 = *(const f32x4*)(ada + 2 * D + colw + 16 * nt);
#pragma unroll
        for (int mt = 0; mt < 4; ++mt) { const f32x4 xv = *(const f32x4*)(F.x + (size_t)(m0 + 16 * mt + fr) * D + colw + 16 * nt); acc[mt][nt] = ALPHA * xv + g1 * acc[mt][nt]; }
        asm volatile("" : "+v"(acc[0][nt]), "+v"(acc[1][nt]), "+v"(acc[2][nt]), "+v"(acc[3][nt]) :: "memory"); }
    float mean[4], rstd[4];
    row_stats(acc, (LAS float*)(lds + P3_RED), w, lane, mean, rstd);
#pragma unroll
    for (int nt = 0; nt < 8; ++nt) { const int col = colw + 16 * nt;
        const f32x4 g = *(const f32x4*)(F.ln1_g + col), be = *(const f32x4*)(F.ln1_b + col), s2 = *(const f32x4*)(ada + 4 * D + col), h2s = *(const f32x4*)(ada + 3 * D + col);
#pragma unroll
        for (int mt = 0; mt < 4; ++mt) { const f32x4 x1 = (acc[mt][nt] - mean[mt]) * rstd[mt] * g + be;
            *(f32x4*)(F.out + (size_t)(m0 + 16 * mt + fr) * D + col) = x1;
            const f32x4 h2 = x1 * (1.f + s2) + h2s;
            v2u pk; pk.x = pk2(h2[0], h2[1]); pk.y = pk2(h2[2], h2[3]);
            *(LAS v2u*)(lds + (16 * mt + fr) * H_STRIDE + col * 2) = pk; }
        __builtin_amdgcn_sched_barrier(0); }
    LDS_WAIT(); __syncthreads();
    { const int mt = w >> 1, kh = w & 1; const int lane = lane_now(), fr = lane & 15, fq = lane >> 4;
      f32x4 rl[3];
#pragma unroll
      for (int nt = 0; nt < 3; ++nt) rl[nt] = (f32x4){0.f, 0.f, 0.f, 0.f};
      const unsigned char* wr = F.ws + WS_WR + lane * 16;
#pragma unroll 4
      for (int ks = 16 * kh; ks < 16 * kh + 16; ++ks) { const bf16x8 af = *(const LAS bf16x8*)(lds + (16 * mt + fr) * H_STRIDE + ks * 64 + fq * 16);
#pragma unroll
          for (int nt = 0; nt < 3; ++nt) { const bf16x8 bf = *(const bf16x8*)(wr + (size_t)(ks * 3 + nt) * 1024); rl[nt] = __builtin_amdgcn_mfma_f32_16x16x32_bf16(bf, af, rl[nt], 0, 0, 0); } }
      LAS float* lg = (LAS float*)(lds + P3_LG) + kh * (64 * 48) + (16 * mt + fr) * 48 + 4 * fq;
#pragma unroll
      for (int nt = 0; nt < 3; ++nt) *(LAS f32x4*)(lg + 16 * nt) = rl[nt]; }
    LDS_WAIT(); __syncthreads();
    if (w == 0) { const int lane = lane_now(); const LAS float* l0 = (const LAS float*)(lds + P3_LG) + lane * 48; const LAS float* l1 = l0 + 64 * 48;
        float gl[4]; int gi = 0;
#pragma unroll
        for (int j = 0; j < 4; ++j) gl[j] = l0[j] + l1[j] + F.brg[j];
        float gm = gl[0];
#pragma unroll
        for (int j = 1; j < 4; ++j) if (gl[j] > gm) { gm = gl[j]; gi = j; }
        float gs = 0.f;
#pragma unroll
        for (int j = 0; j < 4; ++j) gs += expf(gl[j] - gm);
        const float gprob = 1.f / gs;
        float el[8];
#pragma unroll
        for (int j = 0; j < 8; ++j) el[j] = l0[4 + gi * 8 + j] + l1[4 + gi * 8 + j] + F.bre[gi * 8 + j];
        int i1 = 0; float m1 = el[0];
#pragma unroll
        for (int j = 1; j < 8; ++j) if (el[j] > m1) { m1 = el[j]; i1 = j; }
        int i2 = -1; float m2 = -3.0e38f;
#pragma unroll
        for (int j = 0; j < 8; ++j) if (j != i1 && el[j] > m2) { m2 = el[j]; i2 = j; }
        const float w1 = 1.f / (1.f + expf(m2 - m1)), w2 = 1.f - w1;
        const int ea = i1 < i2 ? i1 : i2, eb = i1 < i2 ? i2 : i1;
        const float wa = (i1 < i2 ? w1 : w2) * gprob, wb = (i1 < i2 ? w2 : w1) * gprob;
        const int m = m0 + lane;
        ((int*)(F.ws + WS_RC))[m] = gi * 28 + (ea * (15 - ea)) / 2 + (eb - ea - 1);
        *(f32x2*)((float*)(F.ws + WS_RW) + 2 * m) = (f32x2){wa, wb};
        ((int*)(F.ws + WS_RE))[2 * m] = gi * 8 + ea; ((int*)(F.ws + WS_RE))[2 * m + 1] = gi * 8 + eb;
    }
    { bf16* H2 = (bf16*)(F.ws + WS_H2); const int tid = w * 64 + lane_now();
#pragma unroll
      for (int i = 0; i < 16; ++i) { const int p = i * NTHR + tid, row = p >> 7, ch = p & 127;
          const v4u v = *(const LAS v4u*)(lds + row * H_STRIDE + ch * 16); *(v4u*)(H2 + (size_t)(m0 + row) * D + ch * 8) = v; } }
    LDS_WAIT(); __syncthreads();
}
constexpr int P4_A = 0;
constexpr int P4_RED = 64 * H_STRIDE;
constexpr int P4_TOK = P4_RED + 4096;
constexpr int P4_RW = P4_TOK + 256;
constexpr int P4_HIST = P4_RW + 512;
constexpr int P4_TSTART = P4_HIST + 512;
constexpr int P4_WSUM = P4_TSTART + 512;
constexpr int P4_CID = P4_WSUM + 64;
constexpr int P4_END = P4_CID + T;
static_assert(P4_END + 256 <= LDS_BYTES, "P4 LDS map");

template <int NKS>
__device__ __forceinline__ void panel_gemm4(f32x4 (&acc)[4][4], const LAS unsigned char* a0, int astride, const unsigned char* bp) {
    bf16x8 Bc[4], Bn[4], Af[4];
#pragma unroll
    for (int nt = 0; nt < 4; ++nt) Bc[nt] = *(const bf16x8*)(bp + nt * 1024);
#pragma unroll
    for (int nt = 0; nt < 4; ++nt) Bn[nt] = *(const bf16x8*)(bp + 4096 + nt * 1024);
#pragma unroll 1
    for (int ks = 0; ks < NKS; ks += 2) {
        const unsigned char* b2 = bp + (size_t)(ks + 2 < NKS ? ks + 2 : ks) * 4096;
#pragma unroll
        for (int mt = 0; mt < 4; ++mt) Af[mt] = *(const LAS bf16x8*)(a0 + mt * 16 * astride + ks * 64);
#pragma unroll
        for (int nt = 0; nt < 4; ++nt) {
#pragma unroll
            for (int mt = 0; mt < 4; ++mt) acc[mt][nt] = __builtin_amdgcn_mfma_f32_16x16x32_bf16(Bc[nt], Af[mt], acc[mt][nt], 0, 0, 0);
            Bc[nt] = *(const bf16x8*)(b2 + nt * 1024);
        }
#pragma unroll
        for (int mt = 0; mt < 4; ++mt) Af[mt] = *(const LAS bf16x8*)(a0 + mt * 16 * astride + (ks + 1) * 64);
#pragma unroll
        for (int nt = 0; nt < 4; ++nt) {
#pragma unroll
            for (int mt = 0; mt < 4; ++mt) acc[mt][nt] = __builtin_amdgcn_mfma_f32_16x16x32_bf16(Bn[nt], Af[mt], acc[mt][nt], 0, 0, 0);
            Bn[nt] = *(const bf16x8*)(b2 + 4096 + nt * 1024);
        }
    }
}

__device__ __forceinline__ void p4_tile(Frame& F, int combo, int n  ) {
    const int w = F.wave;
    LAS unsigned char* lds = F.lds;
    const LAS int* tok = (const LAS int*)(lds + P4_TOK);
    const LAS float* rw = (const LAS float*)(lds + P4_RW);
    const int g = combo / 28, pi = combo % 28;
    int ea = 0, rem = pi; while (rem >= 7 - ea) { rem -= 7 - ea; ++ea; }
    const int eb = ea + 1 + rem;
    const int ex[2] = {g * 8 + ea, g * 8 + eb};
    { const bf16* H2 = (const bf16*)(F.ws + WS_H2); const int tid = w * 64 + lane_now();
#pragma unroll
      for (int i = 0; i < 16; ++i) { const int p = i * NTHR + tid, row = p >> 7, ch = p & 127;
          const v4u v = *(const v4u*)(H2 + (size_t)tok[row] * D + ch * 8); *(LAS v4u*)(lds + P4_A + row * H_STRIDE + ch * 16) = v; } }
    LDS_WAIT(); __syncthreads();
    unsigned hp[2][4][2][2];
#pragma unroll
    for (int s = 0; s < 2; ++s) { const int lane = lane_now(), fr = lane & 15, fq = lane >> 4;
        f32x4 a1[4][4];
#pragma unroll
        for (int mt = 0; mt < 4; ++mt)
#pragma unroll
            for (int nt = 0; nt < 4; ++nt) a1[mt][nt] = (f32x4){0.f, 0.f, 0.f, 0.f};
        const int e = s ? ex[1] : ex[0];
        panel_gemm4<32>(a1, lds + P4_A + fr * H_STRIDE + fq * 16, H_STRIDE, F.ws + WS_WGU + (size_t)(e * 8 + w) * 32 * 4096 + lane * 16);
#pragma unroll
        for (int mt = 0; mt < 4; ++mt) { const float cw = rw[(16 * mt + fr) * 2 + s];
#pragma unroll
            for (int nt = 0; nt < 2; ++nt) { const f32x4 gv = a1[mt][nt], uv = a1[mt][2 + nt]; float hv[4];
#pragma unroll
                for (int j = 0; j < 4; ++j) { const float sg = gv[j] * __builtin_amdgcn_rcpf(1.f + __builtin_amdgcn_exp2f(-1.4426950408889634f * gv[j])); hv[j] = sg * uv[j] * cw; }
                hp[s][mt][nt][0] = pk2(hv[0], hv[1]); hp[s][mt][nt][1] = pk2(hv[2], hv[3]); } }
    }
    __syncthreads();
    const int lane = lane_now(), fr = lane & 15, fq = lane >> 4;
#pragma unroll
    for (int s = 0; s < 2; ++s)
#pragma unroll
        for (int mt = 0; mt < 4; ++mt)
#pragma unroll
            for (int nt = 0; nt < 2; ++nt) { v2u pk; pk.x = hp[s][mt][nt][0]; pk.y = hp[s][mt][nt][1];
                *(LAS v2u*)(lds + P4_A + (16 * mt + fr) * A_STRIDE + (s * 256 + 32 * w + 16 * nt + 4 * fq) * 2) = pk; }
    LDS_WAIT(); __syncthreads();
    f32x4 acc[4][8];
#pragma unroll
    for (int mt = 0; mt < 4; ++mt)
#pragma unroll
        for (int nt = 0; nt < 8; ++nt) acc[mt][nt] = (f32x4){0.f, 0.f, 0.f, 0.f};
    panel_gemm8<8>(acc, lds + P4_A + fr * A_STRIDE + fq * 16, A_STRIDE, F.ws + WS_WD + (size_t)(ex[0] * 8 + w) * 8 * 8192 + lane * 16);
    panel_gemm8<8>(acc, lds + P4_A + fr * A_STRIDE + fq * 16 + 512, A_STRIDE, F.ws + WS_WD + (size_t)(ex[1] * 8 + w) * 8 * 8192 + lane * 16);
    const float* ada = (const float*)(F.ws + WS_ADA);
    const int colw = 128 * w + 4 * fq;
    int tk[4];
#pragma unroll
    for (int mt = 0; mt < 4; ++mt) tk[mt] = tok[16 * mt + fr];
#pragma unroll
    for (int mt = 0; mt < 4; ++mt) { const float* g2p = ada + (tk[mt] / SEQ) * 6 * D + 5 * D + colw; const float* xp = F.out + (size_t)tk[mt] * D + colw;
#pragma unroll
        for (int nt = 0; nt < 8; ++nt) { const f32x4 g2 = *(const f32x4*)(g2p + 16 * nt), xv = *(const f32x4*)(xp + 16 * nt); acc[mt][nt] = ALPHA * xv + g2 * acc[mt][nt];
            if (nt & 1) asm volatile("" : "+v"(acc[mt][nt - 1]), "+v"(acc[mt][nt]) :: "memory"); } }
    float mean[4], rstd[4];
    row_stats(acc, (LAS float*)(lds + P4_RED), w, lane, mean, rstd);
#pragma unroll
    for (int nt = 0; nt < 8; ++nt) { const int col = colw + 16 * nt; const f32x4 gg = *(const f32x4*)(F.ln2_g + col), be = *(const f32x4*)(F.ln2_b + col);
#pragma unroll
        for (int mt = 0; mt < 4; ++mt) if (16 * mt + fr < n) *(f32x4*)(F.out + (size_t)tk[mt] * D + col) = (acc[mt][nt] - mean[mt]) * rstd[mt] * gg + be;
        __builtin_amdgcn_sched_barrier(0); }
    LDS_WAIT(); __syncthreads();
}

__device__ __forceinline__ void p4_moe(Frame& F) {
    LAS unsigned char* lds = F.lds;
    LAS int* hist = (LAS int*)(lds + P4_HIST); LAS int* tstart = (LAS int*)(lds + P4_TSTART); LAS int* wsum = (LAS int*)(lds + P4_WSUM);
    LAS int* tok = (LAS int*)(lds + P4_TOK); LAS float* rwl = (LAS float*)(lds + P4_RW);
    const int* RC = (const int*)(F.ws + WS_RC); const float* RW = (const float*)(F.ws + WS_RW);
    { const int tid0 = F.wave * 64 + lane_now(); if (tid0 < 128) hist[tid0] = 0; }
    __syncthreads();
    { const int tid = F.wave * 64 + lane_now(); LAS unsigned char* cidp = lds + P4_CID + 32 * tid;
      unsigned pw[8];
#pragma unroll
      for (int i = 0; i < 8; ++i) { const v4u v = *(const v4u*)(RC + 32 * tid + 4 * i);
          __hip_atomic_fetch_add(&hist[v.x], 1, __ATOMIC_RELAXED, __HIP_MEMORY_SCOPE_WORKGROUP); __hip_atomic_fetch_add(&hist[v.y], 1, __ATOMIC_RELAXED, __HIP_MEMORY_SCOPE_WORKGROUP); __hip_atomic_fetch_add(&hist[v.z], 1, __ATOMIC_RELAXED, __HIP_MEMORY_SCOPE_WORKGROUP); __hip_atomic_fetch_add(&hist[v.w], 1, __ATOMIC_RELAXED, __HIP_MEMORY_SCOPE_WORKGROUP);
          pw[i] = (v.x & 0xffu) | ((v.y & 0xffu) << 8) | ((v.z & 0xffu) << 16) | ((v.w & 0xffu) << 24); }
      *(LAS v4u*)(cidp) = (v4u){pw[0], pw[1], pw[2], pw[3]}; *(LAS v4u*)(cidp + 16) = (v4u){pw[4], pw[5], pw[6], pw[7]}; }
    __syncthreads();
    if (F.wave == 0 && lane_now() == 0) { int s = 0; for (int c = 0; c < NCOMBO; ++c) { tstart[c] = s; s += (hist[c] + 63) >> 6; } tstart[NCOMBO] = s; }
    __syncthreads();
    const int ntile = tstart[NCOMBO];
    for (int tile = F.vcu; tile < ntile; tile += F.G) {
        const int lane = lane_now(), tid = F.wave * 64 + lane; const LAS unsigned char* cidp = lds + P4_CID + 32 * tid;
        int c = 0; while (tstart[c + 1] <= tile) ++c;
        const int j = tile - tstart[c], n = min(64, hist[c] - 64 * j);
        unsigned wv[8];
        { const v4u q0 = *(const LAS v4u*)(cidp), q1 = *(const LAS v4u*)(cidp + 16); wv[0] = q0.x; wv[1] = q0.y; wv[2] = q0.z; wv[3] = q0.w; wv[4] = q1.x; wv[5] = q1.y; wv[6] = q1.z; wv[7] = q1.w; }
        int cnt = 0;
#pragma unroll
        for (int i = 0; i < 32; ++i) cnt += (((wv[i >> 2] >> (8 * (i & 3))) & 0xffu) == (unsigned)c) ? 1 : 0;
        int inc = cnt;
#pragma unroll
        for (int o = 1; o < 64; o <<= 1) { const int v = __builtin_amdgcn_ds_bpermute((lane >= o ? lane - o : lane) << 2, inc); if (lane >= o) inc += v; }
        if (lane == 63) wsum[F.wave] = inc;
        __syncthreads();
        int base = inc - cnt;
        for (int ww = 0; ww < F.wave; ++ww) base += wsum[ww];
        if (tid < 64) { tok[tid] = -1; }
        __syncthreads();
#pragma unroll
        for (int i = 0; i < 32; ++i) if (((wv[i >> 2] >> (8 * (i & 3))) & 0xffu) == (unsigned)c) { if ((base >> 6) == j) tok[base & 63] = 32 * tid + i; ++base; }
        __syncthreads();
        if (tid < 64) { int tkn = tok[tid]; if (tkn < 0) { tkn = tok[0]; tok[tid] = tkn; } const f32x2 ww = *(const f32x2*)(RW + 2 * tkn); rwl[2 * tid] = ww.x; rwl[2 * tid + 1] = ww.y; }
        __syncthreads();
        p4_tile(F, c, n);
    }
}
struct Args { const float* in[18]; float* out; unsigned char* ws; int ph_lo, ph_hi; };
__global__ void __launch_bounds__(NTHR, 2) mk_fwd(Args args) {
    extern __shared__ __attribute__((aligned(16))) unsigned char lds[];
    Frame F;
    F.lds = (LAS unsigned char*)lds;
    F.tid = threadIdx.x; F.lane = F.tid & 63; F.wave = __builtin_amdgcn_readfirstlane(F.tid >> 6);
    F.G = gridDim.x; { const int bx = blockIdx.x; F.vcu = (F.G % 8 == 0) ? (bx % 8) * (F.G / 8) + bx / 8 : bx; }
    F.x = args.in[0]; F.c = args.in[1]; F.w_ada = args.in[2]; F.b_ada = args.in[3]; F.w_in = args.in[4]; F.conv_w = args.in[5]; F.w_out = args.in[6];
    F.ln1_g = args.in[7]; F.ln1_b = args.in[8]; F.wrg = args.in[9]; F.brg = args.in[10]; F.wre = args.in[11]; F.bre = args.in[12];
    F.wg = args.in[13]; F.wu = args.in[14]; F.wd = args.in[15]; F.ln2_g = args.in[16]; F.ln2_b = args.in[17];
    F.out = args.out; F.ws = args.ws; F.ctl = (gu32*)(args.ws + WS_CTL);
    volatile LAS unsigned* MISC = (volatile LAS unsigned*)(F.lds + MISC_OFF);
    if (F.tid < 64) MISC[F.tid] = 0u;
    __syncthreads();
    const int lo = args.ph_lo, hi = args.ph_hi;
    const bool multi = (hi - lo) > 1;
    XcdBarrier bar; bar.bar = (unsigned*)(F.ctl + CW_BAR); bar.x = 0; bar.st = nullptr;
    if (multi) bar = xcd_barrier_post((unsigned*)(F.ctl + CW_BAR), MISC + 8);
#ifndef MK_PH_MASK
#define MK_PH_MASK 15
#endif
#define IN(k) (((MK_PH_MASK >> (k)) & 1) && lo <= (k) && (k) < hi)
#define BOTH(k) (IN(k) && IN((k) + 1))
    if (IN(0)) { p0_prologue(F); if (BOTH(0)) xcd_barrier(bar); }
    if (IN(1)) {
        pg8::Gemm g{(const pg8::bf16_t*)(F.ws + WS_HX), (const pg8::bf16_t*)(F.ws + WS_WIN), T, DPROJ, D}; pg8::StaticOrder S; S.init(T, DPROJ, F.G, (int)blockIdx.x);
        pg8::EpiProj E{(pg8::bf16_t*)(F.ws + WS_PROJ), DPROJ, DATT / 256, QSCALE};
        pg8::gemm_phase<pg8::EpiProj, pg8::StaticOrder, true, true>(F.lds, g, S, E);
        if (BOTH(1)) xcd_barrier(bar);
    }
    if (IN(2)) {
        if (F.vcu < T / 64) p3_panel(F, F.vcu);
        if (BOTH(2)) xcd_barrier(bar);
    }
    if (IN(3)) p4_moe(F);
#undef IN
#undef BOTH
}

#if MK_STAGE < 4
template <class ALoad, class BLoad, class Epi>
__global__ void __launch_bounds__(256) k_sgemm(int M, int N, int K, ALoad al, BLoad bl, Epi ep) {
    __shared__ float As[16][65];
    __shared__ float Bs[16][65];
    const int tx = threadIdx.x & 15, ty = threadIdx.x >> 4;
    const int m0 = blockIdx.y * 64, n0 = blockIdx.x * 64;
    float acc[4][4] = {};
    for (int k0 = 0; k0 < K; k0 += 16) {
        for (int i = threadIdx.x; i < 64 * 16; i += 256) { const int mm = i >> 4, kk = i & 15; As[kk][mm] = al(m0 + mm, k0 + kk); }
        for (int i = threadIdx.x; i < 64 * 16; i += 256) { const int kk = i >> 6, nn = i & 63; Bs[kk][nn] = bl(k0 + kk, n0 + nn); }
        __syncthreads();
#pragma unroll
        for (int kk = 0; kk < 16; ++kk) {
            float a[4], b[4];
#pragma unroll
            for (int i = 0; i < 4; ++i) { a[i] = As[kk][ty * 4 + i]; b[i] = Bs[kk][tx * 4 + i]; }
#pragma unroll
            for (int i = 0; i < 4; ++i)
#pragma unroll
                for (int j = 0; j < 4; ++j) acc[i][j] += a[i] * b[j];
        }
        __syncthreads();
    }
#pragma unroll
    for (int i = 0; i < 4; ++i)
#pragma unroll
        for (int j = 0; j < 4; ++j) ep(m0 + ty * 4 + i, n0 + tx * 4 + j, acc[i][j]);
}

struct BLoadPlain { const float* w; int ldw; int pad; __device__ float operator()(int k, int n) const { return w[(size_t)k * ldw + n]; } };
struct EpiStore { float* c; int ldc; int pad; __device__ void operator()(int m, int n, float v) const { c[(size_t)m * ldc + n] = v; } };

struct ALoadMixF { const float* mix; __device__ float operator()(int m, int k) const { return mix[(size_t)m * D + k]; } };
__global__ void __launch_bounds__(64) k_attn_b(const bf16* __restrict__ proj, float* __restrict__ mixin) {
    const int gid = blockIdx.x * blockDim.x + threadIdx.x;
    const int t = gid % SEQ, h = (gid / SEQ) % NH, b = gid / (SEQ * NH);
    float q[HD], o[HD];
    const size_t rowq = ((size_t)(b * SEQ + t)) * DPROJ + h * HD;
#pragma unroll
    for (int d = 0; d < HD; ++d) { q[d] = bf2f(proj[rowq + d]); o[d] = 0.f; }
    float P = 1.f;
    for (int s = t - 1; s >= 0; --s) {
        const bf16* kr = proj + ((size_t)(b * SEQ + s)) * DPROJ + DATT + h * HD;
        const bf16* vr = proj + ((size_t)(b * SEQ + s)) * DPROJ + 2 * DATT + h * HD;
        float z = 0.f;
#pragma unroll
        for (int d = 0; d < HD; ++d) z += q[d] * bf2f(kr[d]);
        const float e = exp2f(z); const float r = 1.f / (1.f + e); const float a = (1.f - r) * P;
#pragma unroll
        for (int d = 0; d < HD; ++d) o[d] += a * bf2f(vr[d]);
        P *= r;
        if (P < 1e-30f) break;
    }
#pragma unroll
    for (int d = 0; d < HD; ++d) mixin[(size_t)(b * SEQ + t) * D + h * HD + d] = o[d];
}
__global__ void k_conv_b(const bf16* __restrict__ proj, const float* __restrict__ conv_w, float* __restrict__ mixin) {
    const int gid = blockIdx.x * blockDim.x + threadIdx.x;
    const int c = gid % DCONV, m = gid / DCONV, t = m % SEQ;
    float y = 0.f;
#pragma unroll
    for (int kk = 0; kk < 3; ++kk) { const int tt = t - 2 + kk; if (tt >= 0) { const size_t r = (size_t)(m - 2 + kk) * DPROJ; y += conv_w[kk * DCONV + c] * bf2f(proj[r + 2048 + c]) * bf2f(proj[r + 2560 + c]); } }
    mixin[(size_t)m * D + DATT + c] = bf2f(proj[(size_t)m * DPROJ + 1536 + c]) * y;
}
__global__ void __launch_bounds__(256) k_ln(float* io, const float* res, const float* __restrict__ ada, int gate_idx, const float* __restrict__ g, const float* __restrict__ beta) {
    __shared__ float red[256];
    const int m = blockIdx.x, b = m / SEQ, tid = threadIdx.x;
    float v[4]; float s = 0.f;
#pragma unroll
    for (int i = 0; i < 4; ++i) { const int d = tid + 256 * i; v[i] = ALPHA * res[(size_t)m * D + d] + ada[b * 6 * D + gate_idx * D + d] * io[(size_t)m * D + d]; s += v[i]; }
    red[tid] = s; __syncthreads();
    for (int o = 128; o > 0; o >>= 1) { if (tid < o) red[tid] += red[tid + o]; __syncthreads(); }
    const float mu = red[0] / D; __syncthreads();
    float s2 = 0.f;
#pragma unroll
    for (int i = 0; i < 4; ++i) { const float dd = v[i] - mu; s2 += dd * dd; }
    red[tid] = s2; __syncthreads();
    for (int o = 128; o > 0; o >>= 1) { if (tid < o) red[tid] += red[tid + o]; __syncthreads(); }
    const float rstd = 1.f / sqrtf(red[0] / D + LN_EPS);
#pragma unroll
    for (int i = 0; i < 4; ++i) { const int d = tid + 256 * i; io[(size_t)m * D + d] = (v[i] - mu) * rstd * g[d] + beta[d]; }
}

__global__ void __launch_bounds__(256) k_router(const float* __restrict__ x1, const float* __restrict__ ada, const float* __restrict__ wrg, const float* __restrict__ brg,
                                                const float* __restrict__ wre, const float* __restrict__ bre, int* __restrict__ r_e, float* __restrict__ r_w) {
    __shared__ float lg[4][36];
    const int m = blockIdx.x * 4 + (threadIdx.x >> 6), lane = threadIdx.x & 63, b = m / SEQ;
    float acc[36];
#pragma unroll
    for (int j = 0; j < 36; ++j) acc[j] = 0.f;
    for (int k = lane; k < D; k += 64) {
        const float hv = x1[(size_t)m * D + k] * (1.f + ada[b * 6 * D + 4 * D + k]) + ada[b * 6 * D + 3 * D + k];
#pragma unroll
        for (int j = 0; j < 4; ++j) acc[j] += hv * wrg[k * NG + j];
#pragma unroll
        for (int j = 0; j < 32; ++j) acc[4 + j] += hv * wre[k * NE + j];
    }
#pragma unroll
    for (int j = 0; j < 36; ++j) { float v = acc[j]; for (int o = 32; o > 0; o >>= 1) v += __shfl_xor(v, o); if (lane == 0) lg[threadIdx.x >> 6][j] = v; }
    if (lane == 0) {
        const float* L = lg[threadIdx.x >> 6];
        float gl[4]; int gi = 0;
        for (int j = 0; j < 4; ++j) gl[j] = L[j] + brg[j];
        float gm = gl[0]; for (int j = 1; j < 4; ++j) if (gl[j] > gm) { gm = gl[j]; gi = j; }
        float gs = 0.f; for (int j = 0; j < 4; ++j) gs += expf(gl[j] - gm);
        const float gprob = 1.f / gs;
        float el[8];
        for (int j = 0; j < 8; ++j) el[j] = L[4 + gi * 8 + j] + bre[gi * 8 + j];
        int i1 = 0; for (int j = 1; j < 8; ++j) if (el[j] > el[i1]) i1 = j;
        int i2 = (i1 == 0) ? 1 : 0; for (int j = 0; j < 8; ++j) if (j != i1 && el[j] > el[i2]) i2 = j;
        const float w1 = 1.f / (1.f + expf(el[i2] - el[i1])), w2 = 1.f - w1;
        r_e[m * 2 + 0] = gi * 8 + i1; r_e[m * 2 + 1] = gi * 8 + i2;
        r_w[m * 2 + 0] = w1 * gprob; r_w[m * 2 + 1] = w2 * gprob;
    }
}

__global__ void __launch_bounds__(256) k_moe_hid(const float* __restrict__ x1, const float* __restrict__ ada, const int* __restrict__ r_e,
                                                 const float* __restrict__ wg, const float* __restrict__ wu, float* __restrict__ hid) {
    __shared__ float hs[D];
    const int m = blockIdx.x, kk = blockIdx.y, f = threadIdx.x, b = m / SEQ;
    for (int k = threadIdx.x; k < D; k += 256) hs[k] = x1[(size_t)m * D + k] * (1.f + ada[b * 6 * D + 4 * D + k]) + ada[b * 6 * D + 3 * D + k];
    __syncthreads();
    const int e = r_e[m * 2 + kk];
    const float* g = wg + (size_t)e * D * DEXP + f; const float* u = wu + (size_t)e * D * DEXP + f;
    float ag = 0.f, au = 0.f;
    for (int k = 0; k < D; ++k) { ag += hs[k] * g[(size_t)k * DEXP]; au += hs[k] * u[(size_t)k * DEXP]; }
    hid[((size_t)m * 2 + kk) * DEXP + f] = ag / (1.f + expf(-ag)) * au;
}
__global__ void __launch_bounds__(256) k_moe_down(const float* __restrict__ hid, const int* __restrict__ r_e, const float* __restrict__ r_w,
                                                  const float* __restrict__ wd, float* __restrict__ y) {
    __shared__ float hs[2 * DEXP];
    const int m = blockIdx.x;
    for (int i = threadIdx.x; i < 2 * DEXP; i += 256) hs[i] = hid[(size_t)m * 2 * DEXP + i];
    __syncthreads();
    for (int d = threadIdx.x; d < D; d += 256) {
        float acc = 0.f;
        for (int kk = 0; kk < 2; ++kk) { const int e = r_e[m * 2 + kk]; const float* w = wd + (size_t)e * DEXP * D + d; float a = 0.f;
            for (int f = 0; f < DEXP; ++f) a += hs[kk * DEXP + f] * w[(size_t)f * D];
            acc += r_w[m * 2 + kk] * a; }
        y[(size_t)m * D + d] = acc;
    }
}
__global__ void k_copy(float* dst, const float* src, size_t n) { const size_t i = (size_t)blockIdx.x * 256 + threadIdx.x; if (i < n) dst[i] = src[i]; }


#endif
extern "C" void kernel_launch(void* const* d_in, const int* in_sizes, int n_in, void* d_out, int out_size, void* d_ws, size_t ws_size, hipStream_t stream) {
    static int grid = 0;
    if (grid == 0) {
        if (n_in != 18 || out_size != T * D || ws_size < WS_END) { fprintf(stderr, "kernel_launch: unexpected shapes (n_in %d, out %d, ws %zu)\n", n_in, out_size, ws_size); grid = -1; return; }
        int dev = 0, cus = 0, per_cu = 0;
        if (hipGetDevice(&dev) != hipSuccess || hipDeviceGetAttribute(&cus, hipDeviceAttributeMultiprocessorCount, dev) != hipSuccess) { grid = -1; return; }
        if (hipFuncSetAttribute((const void*)mk_fwd, hipFuncAttributeMaxDynamicSharedMemorySize, LDS_BYTES) != hipSuccess) { fprintf(stderr, "kernel_launch: hipFuncSetAttribute failed\n"); grid = -1; return; }
        if (hipOccupancyMaxActiveBlocksPerMultiprocessor(&per_cu, (const void*)mk_fwd, NTHR, LDS_BYTES) != hipSuccess || per_cu < 1) fprintf(stderr, "kernel_launch: occupancy query says %d blocks/CU\n", per_cu);
        (void)hipGetLastError();
        grid = cus;
    }
    if (grid < 0) return;
    (void)hipMemsetAsync((char*)d_ws + WS_CTL, 0, CTL_ZERO_BYTES, stream);
    Args a{};
    for (int i = 0; i < 18; ++i) a.in[i] = (const float*)d_in[i];
    a.out = (float*)d_out; a.ws = (unsigned char*)d_ws;
#if MK_STAGE == 4
    a.ph_lo = 0; a.ph_hi = 4;
    hipLaunchKernelGGL(mk_fwd, dim3(grid), dim3(NTHR), LDS_BYTES, stream, a);
#else
    const int nfast = MK_STAGE + 1;
    for (int p = 0; p < nfast; ++p) { a.ph_lo = p; a.ph_hi = p + 1; hipLaunchKernelGGL(mk_fwd, dim3(grid), dim3(NTHR), LDS_BYTES, stream, a); }
    char* ws = (char*)d_ws; float* out = (float*)d_out;
    const float* x = (const float*)d_in[0];
    const float* ada = (const float*)(ws + WS_ADA);
    float* ybuf = (float*)(ws + WS_PROJ); float* hid = (float*)(ws + 160 * MiB);
    int* r_e = (int*)(ws + WS_RE); float* r_w = (float*)(ws + WS_RW);
#if MK_STAGE == 1
    float* mixin = (float*)(ws + 192 * MiB);
    k_conv_b<<<T * DCONV / 256, 256, 0, stream>>>((const bf16*)(ws + WS_PROJ), (const float*)d_in[5], mixin);
    k_attn_b<<<BATCH * NH * SEQ / 64, 64, 0, stream>>>((const bf16*)(ws + WS_PROJ), mixin);
    k_sgemm<<<dim3(D / 64, T / 64), 256, 0, stream>>>(T, D, D, ALoadMixF{mixin}, BLoadPlain{(const float*)d_in[6], D, 0}, EpiStore{out, D, 0});
    k_ln<<<T, 256, 0, stream>>>(out, x, ada, 2, (const float*)d_in[7], (const float*)d_in[8]);
    k_router<<<T / 4, 256, 0, stream>>>(out, ada, (const float*)d_in[9], (const float*)d_in[10], (const float*)d_in[11], (const float*)d_in[12], r_e, r_w);
#endif
#if MK_STAGE <= 2
    k_moe_hid<<<dim3(T, 2), 256, 0, stream>>>(out, ada, r_e, (const float*)d_in[13], (const float*)d_in[14], hid);
    k_moe_down<<<T, 256, 0, stream>>>(hid, r_e, r_w, (const float*)d_in[15], ybuf);
    k_ln<<<T, 256, 0, stream>>>(ybuf, out, ada, 5, (const float*)d_in[16], (const float*)d_in[17]);
    k_copy<<<(unsigned)(((size_t)T * D + 255) / 256), 256, 0, stream>>>(out, ybuf, (size_t)T * D);
#endif
#endif
}
```

```cpp
#include <hip/hip_runtime.h>
#include <cstdio>
#include <cstdint>
#ifndef MK_STAGE
#define MK_STAGE 4
#endif
namespace pg8 {
#define PG8_LAS __attribute__((address_space(3)))
typedef unsigned short bf16_t;
typedef short bf16x8 __attribute__((ext_vector_type(8)));
typedef float f32x4 __attribute__((ext_vector_type(4)));
typedef unsigned u32x4 __attribute__((ext_vector_type(4)));
constexpr int BM = 256, BK = 64, HALF = 128, HTB = HALF * BK * 2  , STAGE_BYTES = 8 * HTB, NXCD = 8, WGM = 8;

__host__ __device__ __forceinline__ int lds_byte(int r, int c) { const int st = (r >> 4) * 2 + (c >> 5), rr = r & 15, cc = c & 31, ob = rr * 64 + cc * 2; return st * 1024 + (ob ^ (((ob >> 9) & 1) << 5)); }
__host__ __device__ __forceinline__ void stage_rc(int b, int& R, int& C) { const int st = b / 1024, sb = b % 1024, swz = sb ^ (((sb >> 9) & 1) << 5); R = (st >> 1) * 16 + swz / 64; C = (st & 1) * 32 + (swz % 64) / 2; }
__host__ __device__ __forceinline__ int perm32(int rho) { const int n = rho >> 4, i = rho & 15; return 8 * (i >> 2) + 4 * n + (i & 3); }

struct Unit { int pm, pn; };
struct Gemm { const bf16_t* A; const bf16_t* Bt; int M, N, K; };

struct StaticOrder {
    int nM, nN, nwg, G, c;
    __host__ __device__ void init(int M, int N, int G_, int c_) { nM = M / BM; nN = N / BM; nwg = nM * nN; G = G_; c = c_; }
    __host__ __device__ bool next(int i, Unit& u) const {
        const long L = (long)i * G + c; if (L >= nwg) return false;
        int wgid = (int)L; { const int q = nwg / NXCD, r = nwg % NXCD, xcd = wgid % NXCD, off = wgid / NXCD; wgid = (xcd < r ? xcd * (q + 1) : r * (q + 1) + (xcd - r) * q) + off; }
        const int nig = WGM * nN, gid = wgid / nig, fm = gid * WGM, gsz = (nM - fm) < WGM ? (nM - fm) : WGM;
        u.pm = fm + ((wgid % nig) % gsz); u.pn = (wgid % nig) / gsz; return true;
    }
    __device__ __forceinline__ void a_ready(const Unit&) const {}
    __device__ __forceinline__ void done(const Unit&) const {}
};

__device__ __forceinline__ unsigned cvt_pk_bf16(float lo, float hi) { unsigned r; asm volatile("v_cvt_pk_bf16_f32 %0, %1, %2" : "=v"(r) : "v"(lo), "v"(hi)); return r; }
template <class Epi, class Sched, bool ALIGN_EPI = false, bool SP2 = false>
__device__ __forceinline__ void gemm_phase(PG8_LAS unsigned char* lds, const Gemm g, const Sched& S, const Epi& E) {
    const int tid = threadIdx.x, wid = __builtin_amdgcn_readfirstlane(tid >> 6), lane = tid & 63, wr = wid >> 2, wc = wid & 3, fr = lane & 15, fq = lane >> 4;
    const int K = g.K, nt = K / BK;
    unsigned voffA[2], voffB[2];
#pragma unroll
    for (int i = 0; i < 2; ++i) { int R, C; stage_rc(tid * 16 + i * 8192, R, C); const int Rb = Epi::PERM ? ((R & ~31) + perm32(R & 31)) : R;
        voffA[i] = (unsigned)(R * K + C) * 2u; voffB[i] = (unsigned)(Rb * K + C) * 2u; }
    const size_t kstep = (size_t)(BK * 2);
    const size_t hstep = (size_t)HALF * K * 2;
    const size_t tstep = 2 * hstep;
    const unsigned ldsw = (unsigned)wid * 1024u;
    const int aoff = lds_byte(wr * 64 + fr, fq * 8), boff = lds_byte(wc * 32 + fr, fq * 8);
#define PG8_SA(b, h) (((b) * 2 + (h)) * HTB)
#define PG8_SB(b, h) ((4 + (b) * 2 + (h)) * HTB)
#define PG8_STAGE(bufoff, gbase, voff) do { _Pragma("unroll") for (int _i = 0; _i < 2; ++_i) \
        __builtin_amdgcn_global_load_lds((const unsigned*)((const char*)(gbase) + (voff)[_i]), (PG8_LAS unsigned*)(lds + (bufoff) + ldsw + _i * 8192), 16, 0, 0); } while (0)
#define PG8_LDA(dst, b, h) do { _Pragma("unroll") for (int m = 0; m < 4; ++m) _Pragma("unroll") for (int k = 0; k < 2; ++k) dst[m][k] = *(const PG8_LAS bf16x8*)(lds + PG8_SA(b, h) + aoff + m * 2048 + k * 1024); } while (0)
#define PG8_LDB(dst, b, h) do { _Pragma("unroll") for (int n = 0; n < 2; ++n) _Pragma("unroll") for (int k = 0; k < 2; ++k) dst[n][k] = *(const PG8_LAS bf16x8*)(lds + PG8_SB(b, h) + boff + n * 2048 + k * 1024); } while (0)
#define PG8_MMA(ai, bj, At, Bt) do { __builtin_amdgcn_s_setprio(1); _Pragma("unroll") for (int m = 0; m < 4; ++m) _Pragma("unroll") for (int n = 0; n < 2; ++n) _Pragma("unroll") for (int k = 0; k < 2; ++k) \
        acc[ai][bj][m][n] = __builtin_amdgcn_mfma_f32_16x16x32_bf16(Bt[n][k], At[m][k], acc[ai][bj][m][n], 0, 0, 0); __builtin_amdgcn_s_setprio(0); } while (0)
#define PG8_WAIT_V(n) asm volatile("s_waitcnt vmcnt(" #n ")" ::: "memory")
#define PG8_WAIT_L(n) asm volatile("s_waitcnt lgkmcnt(" #n ")" ::: "memory")
#define PG8_BAR __builtin_amdgcn_s_barrier()
#define PG8_SCHED __builtin_amdgcn_sched_barrier(0)
    Unit cur, nxt; int ui = 0;
    if (!S.next(0, cur)) return;
    f32x4 acc[2][2][4][2];
#pragma unroll
    for (int a = 0; a < 2; ++a)
#pragma unroll
        for (int b = 0; b < 2; ++b)
#pragma unroll
            for (int m = 0; m < 4; ++m)
#pragma unroll
                for (int n = 0; n < 2; ++n) acc[a][b][m][n] = (f32x4){0.f, 0.f, 0.f, 0.f};
    bf16x8 At[4][2], B0[2][2], B1[2][2];
    const char* cA = (const char*)g.A + (size_t)cur.pm * tstep; const char* cB = (const char*)g.Bt + (size_t)cur.pn * tstep;
    S.a_ready(cur);
    if constexpr (SP2) {
        PG8_STAGE(PG8_SB(0, 0), cB, voffB); PG8_STAGE(PG8_SB(0, 1), cB + hstep, voffB); PG8_STAGE(PG8_SA(0, 0), cA, voffA); PG8_STAGE(PG8_SA(0, 1), cA + hstep, voffA);
        if (wr == 1) PG8_BAR;
        PG8_WAIT_V(2); PG8_BAR;
        PG8_STAGE(PG8_SB(1, 0), cB + kstep, voffB); PG8_STAGE(PG8_SA(1, 0), cA + kstep, voffA); PG8_STAGE(PG8_SB(1, 1), cB + hstep + kstep, voffB);
        PG8_WAIT_V(6); PG8_BAR;
    } else {
        PG8_STAGE(PG8_SB(0, 0), cB, voffB); PG8_STAGE(PG8_SA(0, 0), cA, voffA); PG8_STAGE(PG8_SB(0, 1), cB + hstep, voffB); PG8_STAGE(PG8_SA(0, 1), cA + hstep, voffA);
        if (wr == 1) PG8_BAR;
        PG8_WAIT_V(4); PG8_BAR;
        PG8_STAGE(PG8_SB(1, 0), cB + kstep, voffB); PG8_STAGE(PG8_SA(1, 0), cA + kstep, voffA); PG8_STAGE(PG8_SB(1, 1), cB + hstep + kstep, voffB);
        PG8_WAIT_V(6); PG8_BAR;
    }
    for (;;) {
        const bool has_next = S.next(ui + 1, nxt);
        const char* nA = has_next ? (const char*)g.A + (size_t)nxt.pm * tstep : cA; const char* nB = has_next ? (const char*)g.Bt + (size_t)nxt.pn * tstep : cB;
        for (int t = 0; t < nt; t += 2) {
            const bool last = (t == nt - 2);
            const char* a1 = cA + (size_t)(t + 1) * kstep;
            const char* a2 = last ? nA : cA + (size_t)(t + 2) * kstep; const char* b2 = last ? nB : cB + (size_t)(t + 2) * kstep;
            const char* a3 = a2 + kstep; const char* b3 = b2 + kstep;
            if (last && has_next) S.a_ready(nxt);
            if constexpr (SP2) {
            PG8_LDB(B0, 0, 0); PG8_LDB(B1, 0, 1); PG8_SCHED; PG8_LDA(At, 0, 0); PG8_STAGE(PG8_SA(1, 1), a1 + hstep, voffA);
            PG8_WAIT_V(8); PG8_WAIT_L(0); PG8_BAR; PG8_MMA(0, 0, At, B0); PG8_MMA(0, 1, At, B1); PG8_BAR; PG8_SCHED;
            PG8_LDA(At, 0, 1); PG8_STAGE(PG8_SB(0, 0), b2, voffB); PG8_STAGE(PG8_SB(0, 1), b2 + hstep, voffB); PG8_STAGE(PG8_SA(0, 0), a2, voffA);
            PG8_WAIT_V(8); PG8_WAIT_L(0); PG8_BAR; PG8_MMA(1, 0, At, B0); PG8_MMA(1, 1, At, B1); PG8_BAR; PG8_SCHED;
            PG8_LDB(B0, 1, 0); PG8_LDB(B1, 1, 1); PG8_SCHED; PG8_LDA(At, 1, 0); PG8_STAGE(PG8_SA(0, 1), a2 + hstep, voffA);
            PG8_WAIT_V(8); PG8_WAIT_L(0); PG8_BAR; PG8_MMA(0, 0, At, B0); PG8_MMA(0, 1, At, B1); PG8_BAR; PG8_SCHED;
            PG8_LDA(At, 1, 1); PG8_STAGE(PG8_SB(1, 0), b3, voffB); PG8_STAGE(PG8_SB(1, 1), b3 + hstep, voffB); PG8_STAGE(PG8_SA(1, 0), a3, voffA);
            PG8_WAIT_V(8); PG8_WAIT_L(0); PG8_BAR; PG8_MMA(1, 0, At, B0); PG8_MMA(1, 1, At, B1); PG8_BAR; PG8_SCHED;
            } else {
            PG8_LDB(B0, 0, 0); PG8_SCHED; PG8_LDA(At, 0, 0); PG8_STAGE(PG8_SA(1, 1), a1 + hstep, voffA);
            PG8_WAIT_L(8); PG8_BAR; PG8_WAIT_L(0); PG8_MMA(0, 0, At, B0); PG8_BAR; PG8_SCHED;
            PG8_LDB(B1, 0, 1); PG8_STAGE(PG8_SB(0, 0), b2, voffB);
            PG8_BAR; PG8_WAIT_L(0); PG8_MMA(0, 1, At, B1); PG8_BAR;
            PG8_LDA(At, 0, 1); PG8_STAGE(PG8_SA(0, 0), a2, voffA);
            PG8_BAR; PG8_WAIT_L(0); PG8_MMA(1, 0, At, B0); PG8_BAR; PG8_SCHED;
            PG8_STAGE(PG8_SB(0, 1), b2 + hstep, voffB);
            PG8_WAIT_V(6); PG8_BAR; PG8_MMA(1, 1, At, B1); PG8_BAR;
            PG8_LDB(B0, 1, 0); PG8_SCHED; PG8_LDA(At, 1, 0); PG8_STAGE(PG8_SA(0, 1), a2 + hstep, voffA);
            PG8_WAIT_L(8); PG8_BAR; PG8_WAIT_L(0); PG8_MMA(0, 0, At, B0); PG8_BAR; PG8_SCHED;
            PG8_LDB(B1, 1, 1); PG8_STAGE(PG8_SB(1, 0), b3, voffB);
            PG8_BAR; PG8_WAIT_L(0); PG8_MMA(0, 1, At, B1); PG8_BAR;
            PG8_LDA(At, 1, 1); PG8_STAGE(PG8_SA(1, 0), a3, voffA);
            PG8_BAR; PG8_WAIT_L(0); PG8_MMA(1, 0, At, B0); PG8_BAR; PG8_SCHED;
            PG8_STAGE(PG8_SB(1, 1), b3 + hstep, voffB);
            PG8_WAIT_V(6); PG8_BAR; PG8_MMA(1, 1, At, B1); PG8_BAR;
            }
        }
        if constexpr (ALIGN_EPI) { if (wr == 0) PG8_BAR; }
        if constexpr (!Epi::AFTER_DRAIN) { E(acc, cur, wr, wc, fr, fq); S.done(cur); }
        if (!has_next) break;
#pragma unroll
        for (int a = 0; a < 2; ++a)
#pragma unroll
            for (int b = 0; b < 2; ++b)
#pragma unroll
                for (int m = 0; m < 4; ++m)
#pragma unroll
                    for (int n = 0; n < 2; ++n) acc[a][b][m][n] = (f32x4){0.f, 0.f, 0.f, 0.f};
        cur = nxt; cA = nA; cB = nB; ++ui;
        if constexpr (ALIGN_EPI) { if (wr == 1) PG8_BAR; }
    }
    PG8_WAIT_V(0);
    if constexpr (!ALIGN_EPI) { if (wr == 0) PG8_BAR; }
    PG8_BAR;
    if constexpr (Epi::AFTER_DRAIN) { E.fused(acc, cur, wr, wc, fr, fq, lds, wid, lane); S.done(cur); }
#undef PG8_SA
#undef PG8_SB
#undef PG8_STAGE
#undef PG8_LDA
#undef PG8_LDB
#undef PG8_MMA
#undef PG8_WAIT_V
#undef PG8_WAIT_L
#undef PG8_BAR
#undef PG8_SCHED
}
}
namespace pg8 {
struct EpiProj {
    static constexpr bool PERM = true, AFTER_DRAIN = false;
    bf16_t* O; int ldc; int nq; float scale0;
    __device__ __forceinline__ void operator()(const f32x4 (&acc)[2][2][4][2], const Unit& u, int wr, int wc, int fr, int fq) const {
        const int row0 = u.pm * BM + wr * 64 + fr; const int col0 = u.pn * BM + wc * 32 + 8 * fq;
        const float sc = (u.pn < nq) ? scale0 : 1.f;
#pragma unroll
        for (int ai = 0; ai < 2; ++ai)
#pragma unroll
            for (int m = 0; m < 4; ++m) { bf16_t* rowp = O + (size_t)(row0 + ai * HALF + m * 16) * ldc + col0;
#pragma unroll
                for (int bj = 0; bj < 2; ++bj) { f32x4 v0 = acc[ai][bj][m][0] * sc, v1 = acc[ai][bj][m][1] * sc;
                    u32x4 w; w.x = cvt_pk_bf16(v0[0], v0[1]); w.y = cvt_pk_bf16(v0[2], v0[3]); w.z = cvt_pk_bf16(v1[0], v1[1]); w.w = cvt_pk_bf16(v1[2], v1[3]);
                    *(u32x4*)(rowp + bj * HALF) = w; } }
    }
};
}
constexpr int D = 1024, BATCH = 4, SEQ = 4096, T = BATCH * SEQ;
constexpr int DATT = 512, HD = 64, NH = 8, DCONV = 512, DPROJ = 3072;
constexpr int NG = 4, EPG = 8, NE = 32, DEXP = 256, NCOMBO = NG * 28;
constexpr float ALPHA = 1.189207115002721f;
constexpr float LN_EPS = 1e-5f;
constexpr float QSCALE = 0.125f * 1.4426950408889634f;
constexpr float P_STOP = 1e-30f;
constexpr int NWAVES = 8, NTHR = 512;
constexpr int LDS_BYTES = 163840;
constexpr int MISC_OFF = LDS_BYTES - 256;

constexpr size_t MiB = 1u << 20;
constexpr size_t WS_CTL = 0, CTL_ZERO_BYTES = 64 * 1024;
constexpr size_t WS_ADA = 1 * MiB;
constexpr size_t WS_RC = 2 * MiB;
constexpr size_t WS_RW = 2 * MiB + 256 * 1024;
constexpr size_t WS_RE = 2 * MiB + 512 * 1024;
constexpr size_t WS_WR = 3 * MiB;
constexpr size_t WS_WOUT = 4 * MiB;
constexpr size_t WS_WIN = 6 * MiB;
constexpr size_t WS_WGU = 12 * MiB;
constexpr size_t WS_WD = 44 * MiB;
constexpr size_t WS_HX = 64 * MiB;
constexpr size_t WS_PROJ = 96 * MiB;
constexpr size_t WS_H2 = 192 * MiB;
constexpr size_t WS_END = 224 * MiB;
constexpr int CW_ADACNT = 64;
constexpr int CW_WORK0 = 128, CW_WORK1 = 192;
constexpr int CW_BAR = 1024;

#define GAS __attribute__((address_space(1)))
#define LAS __attribute__((address_space(3)))
typedef unsigned short bf16;
typedef unsigned v4u __attribute__((ext_vector_type(4)));
typedef unsigned v2u __attribute__((ext_vector_type(2)));
typedef float f32x4 __attribute__((ext_vector_type(4)));
typedef float f32x2 __attribute__((ext_vector_type(2)));
typedef float f32x16 __attribute__((ext_vector_type(16)));
typedef short bf16x8 __attribute__((ext_vector_type(8)));
typedef short s16x4 __attribute__((ext_vector_type(4)));
typedef GAS unsigned gu32;
#define RLX_AGENT __ATOMIC_RELAXED, __HIP_MEMORY_SCOPE_AGENT
#define LDS_WAIT() asm volatile("s_waitcnt lgkmcnt(0)" ::: "memory")
#define VM_WAIT() asm volatile("s_waitcnt vmcnt(0)" ::: "memory")
typedef __bf16 bf16x2_t __attribute__((ext_vector_type(2)));
__device__ __forceinline__ unsigned pk2(float lo, float hi) { f32x2 v = {lo, hi}; bf16x2_t b = __builtin_convertvector(v, bf16x2_t); return __builtin_bit_cast(unsigned, b); }
__device__ __forceinline__ float bf2f(unsigned short u) { return __builtin_bit_cast(float, (unsigned)u << 16); }
__device__ __forceinline__ float bflo(unsigned u) { return __builtin_bit_cast(float, u << 16); }
__device__ __forceinline__ float bfhi(unsigned u) { return __builtin_bit_cast(float, u & 0xffff0000u); }
__device__ __forceinline__ int lane_now() { int l = (int)__builtin_amdgcn_mbcnt_hi(~0u, __builtin_amdgcn_mbcnt_lo(~0u, 0u)); asm volatile("" : "+v"(l)); return l; }
__device__ __forceinline__ float shx(float v, int m, int lane) { return __builtin_bit_cast(float, __builtin_amdgcn_ds_bpermute((lane ^ m) << 2, __builtin_bit_cast(int, v))); }
#ifdef MK_PROBE_LO
#define PSTAMP(i) do { if (blockIdx.x == 0 && threadIdx.x == 0) ((volatile LAS unsigned*)(pstamp_lds))[(i)] = (unsigned)__builtin_amdgcn_s_memrealtime(); } while (0)
#else
#define PSTAMP(i) do {} while (0)
#endif
#define LBAR() do { asm volatile("s_waitcnt lgkmcnt(0)" ::: "memory"); __builtin_amdgcn_s_barrier(); asm volatile("" ::: "memory"); } while (0)
#define XB_TMO      128
#define XB_XCNT(j)  (256  + 64 * (j))
#define XB_XSUB(j)  (1280 + 64 * (j))
#define XB_XGEN(j)  (2304 + 64 * (j))
#define XB_TOP      3328
#define XB_TOPGEN   3392
#define XCD_BAR_WORDS 3456
#define XB_SPIN_CAP (1u << 18)

__device__ __forceinline__ unsigned xb_ld(unsigned* p)              { return __hip_atomic_load(p, __ATOMIC_RELAXED, __HIP_MEMORY_SCOPE_AGENT); }
__device__ __forceinline__ unsigned xb_add(unsigned* p, unsigned v) { return __hip_atomic_fetch_add(p, v, __ATOMIC_RELAXED, __HIP_MEMORY_SCOPE_AGENT); }
__device__ __forceinline__ unsigned xb_xcc_id() { return (unsigned)__builtin_amdgcn_s_getreg((3 << 11) | 20) & 0xFu; }
#define XB_SPIN(cond, bar) do { unsigned _sp = 0; while (cond) { __builtin_amdgcn_s_sleep(1); \
    if ((++_sp & 255u) == 0u) { if (xb_ld(&(bar)[XB_TMO])) break; if (_sp > XB_SPIN_CAP) { atomicAdd(&(bar)[XB_TMO], 1u); break; } } } } while (0)

struct XcdBarrier {
    unsigned* bar; unsigned x;
    volatile LAS unsigned* st;
};

__device__ __forceinline__ XcdBarrier xcd_barrier_post(unsigned* bar, volatile LAS unsigned* st) {
    XcdBarrier b; b.bar = bar; b.x = xb_xcc_id(); b.st = st;
    if (threadIdx.x == 0) (void)xb_add(&bar[XB_XCNT(b.x)], 1u);
    return b;
}
__device__ __forceinline__ void xcd_barrier_complete(unsigned* bar, unsigned x, unsigned& nloc, unsigned& nx) {
    const unsigned G = gridDim.x * gridDim.y * gridDim.z;
    unsigned sum, cnt, mine, sp = 0u;
    for (;;) {
        sum = 0u; cnt = 0u; mine = 0u;
#pragma unroll
        for (unsigned j = 0; j < 16; ++j) { const unsigned c = xb_ld(&bar[XB_XCNT(j)]); sum += c; cnt += (c > 0u) ? 1u : 0u; mine = (j == x) ? c : mine; }
        if (sum == G) break;
        __builtin_amdgcn_s_sleep(1);
        if ((++sp & 255u) == 0u) { if (xb_ld(&bar[XB_TMO])) break; if (sp > XB_SPIN_CAP) { atomicAdd(&bar[XB_TMO], 1u); break; } }
    }
    nloc = mine > 0u ? mine : 1u; nx = cnt > 0u ? cnt : 1u;
}

__device__ __forceinline__ void xcd_barrier(const XcdBarrier& b) {
    asm volatile("s_waitcnt vmcnt(0)" ::: "memory");
    __syncthreads();
    if (threadIdx.x == 0) {
        unsigned* bar = b.bar;
        __builtin_amdgcn_s_waitcnt(0);
        unsigned nloc = b.st[0], nx = b.st[1];
        if (nloc == 0u) { xcd_barrier_complete(bar, b.x, nloc, nx); b.st[0] = nloc; b.st[1] = nx; }
        const unsigned old = xb_add(&bar[XB_XSUB(b.x)], 1u);
        const unsigned gen = old / nloc;
        if (old + 1u == (gen + 1u) * nloc) {
            __builtin_amdgcn_fence(__ATOMIC_RELEASE, "agent");
            asm volatile("s_waitcnt vmcnt(0)" ::: "memory");
            const unsigned og = xb_add(&bar[XB_TOP], 1u);
            const unsigned tg = og / nx;
            if (og + 1u == (tg + 1u) * nx) xb_add(&bar[XB_TOPGEN], 1u);
            else XB_SPIN(xb_ld(&bar[XB_TOPGEN]) == tg, bar);
            __builtin_amdgcn_fence(__ATOMIC_ACQUIRE, "agent");
            xb_add(&bar[XB_XGEN(b.x)], 1u);
            asm volatile("s_waitcnt vmcnt(0)" ::: "memory");
        } else {
            XB_SPIN(xb_ld(&bar[XB_XGEN(b.x)]) == gen, bar);
            __builtin_amdgcn_fence(__ATOMIC_ACQUIRE, "agent");
            asm volatile("s_waitcnt vmcnt(0)" ::: "memory");
        }
    }
    __syncthreads();
}
struct Frame {
    LAS unsigned char* lds;
    int tid, lane, wave, vcu, G;
    const float *x, *c, *w_ada, *b_ada, *w_in, *conv_w, *w_out, *ln1_g, *ln1_b, *wrg, *brg, *wre, *bre, *wg, *wu, *wd, *ln2_g, *ln2_b;
    float* out; unsigned char* ws; gu32* ctl;
};

#define pstamp_lds (F.lds + MISC_OFF + 64)
constexpr int ADAQ = 4 * 6 * D;
__device__ __forceinline__ f32x4 ada4(const float* p) { return (*(const f32x4*)p + *(const f32x4*)(p + ADAQ)) + (*(const f32x4*)(p + 2 * ADAQ) + *(const f32x4*)(p + 3 * ADAQ)); }
__device__ __forceinline__ void p0_ada_item(Frame& F, int item) {
    LAS float* sc = (LAS float*)F.lds;
    LAS float* red = (LAS float*)(F.lds + 16384);
    for (int i = F.tid; i < 4 * D; i += NTHR) { const float cv = F.c[i]; sc[i] = cv / (1.f + expf(-cv)); }
    __syncthreads();
    const int q = item / 24, n0 = 256 * (item % 24), k0 = 256 * q + 32 * F.wave;
    f32x4 acc[4];
#pragma unroll
    for (int b = 0; b < 4; ++b) acc[b] = (f32x4){0.f, 0.f, 0.f, 0.f};
    const float* wp = F.w_ada + (size_t)k0 * (6 * D) + n0 + 4 * F.lane;
#pragma unroll
    for (int h = 0; h < 2; ++h) { f32x4 wv[16];
#pragma unroll
        for (int i = 0; i < 16; ++i) wv[i] = *(const f32x4*)(wp + (size_t)(16 * h + i) * (6 * D));
#pragma unroll
        for (int i = 0; i < 16; ++i) { const int k = k0 + 16 * h + i;
#pragma unroll
            for (int b = 0; b < 4; ++b) acc[b] += sc[b * D + k] * wv[i]; } }
#pragma unroll
    for (int b = 0; b < 4; ++b) *(LAS f32x4*)(red + (F.wave * 4 + b) * 256 + 4 * F.lane) = acc[b];
    __syncthreads();
    float* adap = (float*)(F.ws + WS_ADA) + q * ADAQ;
    for (int o = F.tid; o < 1024; o += NTHR) { const int b = o >> 8, n = o & 255; float s = 0.f;
#pragma unroll
        for (int w = 0; w < 8; ++w) s += red[(w * 4 + b) * 256 + n];
        __hip_atomic_store(adap + b * 6 * D + n0 + n, s + (q == 0 ? F.b_ada[n0 + n] : 0.f), RLX_AGENT); }
    __syncthreads();
}
__device__ __forceinline__ void p0_transpose_item(const float* W, int K, int N, bf16* WT, LAS float* scr, int item, int lane) {
    const int nblk = N / 32, kb = item / nblk, nb = item % nblk, k0 = 64 * kb, n0 = 32 * nb;
    { float v[32];
#pragma unroll
      for (int i = 0; i < 32; ++i) v[i] = W[(size_t)(k0 + 2 * i + (lane >> 5)) * N + n0 + (lane & 31)];
#pragma unroll
      for (int i = 0; i < 32; ++i) scr[(2 * i + (lane >> 5)) * 33 + (lane & 31)] = v[i]; }
    LDS_WAIT(); asm volatile("" ::: "memory");
    const int c = lane & 7;
#pragma unroll
    for (int j = 0; j < 4; ++j) { const int n = (lane >> 3) + 8 * j; const LAS float* s = scr + (8 * c) * 33 + n;
        v4u o; o.x = pk2(s[0 * 33], s[1 * 33]); o.y = pk2(s[2 * 33], s[3 * 33]); o.z = pk2(s[4 * 33], s[5 * 33]); o.w = pk2(s[6 * 33], s[7 * 33]);
        *(GAS v4u*)(WT + (size_t)(n0 + n) * K + k0 + 8 * c) = o; }
    LDS_WAIT(); asm volatile("" ::: "memory");
}
__device__ __forceinline__ void p0_shuf_item(const float* W, int ldw, int k0, int n0, bf16* dst, int strideA, LAS float* scr, int lane) {
    { f32x2 v[32];
#pragma unroll
      for (int r = 0; r < 32; ++r) v[r] = *(const f32x2*)(W + (size_t)(k0 + r) * ldw + n0 + 2 * lane);
#pragma unroll
      for (int r = 0; r < 32; ++r) *(LAS f32x2*)(scr + r * 130 + 2 * lane) = v[r]; }
    LDS_WAIT(); asm volatile("" ::: "memory");
    const LAS float* s0 = scr + (8 * (lane >> 4)) * 130 + (lane & 15);
#pragma unroll
    for (int nt = 0; nt < 8; ++nt) { const LAS float* s = s0 + 16 * nt;
        v4u o; o.x = pk2(s[0 * 130], s[1 * 130]); o.y = pk2(s[2 * 130], s[3 * 130]); o.z = pk2(s[4 * 130], s[5 * 130]); o.w = pk2(s[6 * 130], s[7 * 130]);
        *(GAS v4u*)(dst + (size_t)(nt >> 1) * strideA + (nt & 1) * 512 + lane * 8) = o; }
    LDS_WAIT(); asm volatile("" ::: "memory");
}
__device__ __forceinline__ void p0_router_item(Frame& F, int ks) {
    bf16* WR = (bf16*)(F.ws + WS_WR); const int lane = F.lane;
#pragma unroll
    for (int nt = 0; nt < 3; ++nt) { const int col = 16 * nt + (lane & 15); float f[8];
#pragma unroll
        for (int j = 0; j < 8; ++j) { const int k = 32 * ks + 8 * (lane >> 4) + j; f[j] = col < NG ? F.wrg[k * NG + col] : (col < NG + NE ? F.wre[k * NE + (col - NG)] : 0.f); }
        v4u o; o.x = pk2(f[0], f[1]); o.y = pk2(f[2], f[3]); o.z = pk2(f[4], f[5]); o.w = pk2(f[6], f[7]);
        *(GAS v4u*)(WR + ((size_t)(ks * 3 + nt) * 64 + lane) * 8) = o; }
}
__device__ __forceinline__ void p0_prologue(Frame& F) {
    constexpr int N_ADA_ITEMS = 4 * (6 * D / 256);
    PSTAMP(30);
    if (F.vcu < N_ADA_ITEMS) {
        p0_ada_item(F, F.vcu);
        VM_WAIT(); __syncthreads();
        if (F.tid == 0) __hip_atomic_fetch_add(F.ctl + CW_ADACNT, 1u, RLX_AGENT);
    }
    PSTAMP(31);
    LAS float* scr = (LAS float*)(F.lds + F.wave * 16640);
    volatile LAS int* bc = (volatile LAS int*)(F.lds + MISC_OFF + 16);
    constexpr int I_WIN = (D / 64) * (DPROJ / 32), I_WOUT = 32 * 8, I_G = NE * 32 * 2, I_U = I_G, I_D = NE * 8 * 8, I_R = 32;
    constexpr int NITEMS = I_WIN + I_WOUT + I_G + I_U + I_D + I_R, NGRP = (NITEMS + NWAVES - 1) / NWAVES;
    for (;;) {
        if (F.tid == 0) *bc = (int)__hip_atomic_fetch_add(F.ctl + CW_WORK0, 1u, RLX_AGENT);
        __syncthreads();
        const int grp = *bc;
        __syncthreads();
        if (grp >= NGRP) break;
        int r = grp * NWAVES + F.wave;
        if (r >= NITEMS) continue;
        if (r < I_WIN) { p0_transpose_item(F.w_in, D, DPROJ, (bf16*)(F.ws + WS_WIN), scr, r, F.lane); continue; } r -= I_WIN;
        if (r < I_WOUT) { const int ks = r >> 3, cb = r & 7; p0_shuf_item(F.w_out, D, 32 * ks, 128 * cb, (bf16*)(F.ws + WS_WOUT) + ((size_t)(cb * 32 + ks) * 8) * 512, 1024, scr, F.lane); continue; } r -= I_WOUT;
        if (r < I_G + I_U) { const int which = r >= I_G ? 1 : 0; if (which) r -= I_G; const int e = r >> 6, ks = (r >> 1) & 31, half = r & 1;
            const float* W = (which ? F.wu : F.wg) + (size_t)e * D * DEXP;
            p0_shuf_item(W, DEXP, 32 * ks, 128 * half, (bf16*)(F.ws + WS_WGU) + ((((size_t)(e * 8 + 4 * half) * 32 + ks) * 4 + which * 2) * 512), 32 * 4 * 512, scr, F.lane); continue; } r -= I_G + I_U;
        if (r < I_D) { const int e = r >> 6, ks = (r >> 3) & 7, cb = r & 7;
            p0_shuf_item(F.wd + (size_t)e * DEXP * D, D, 32 * ks, 128 * cb, (bf16*)(F.ws + WS_WD) + (((size_t)(e * 8 + cb) * 8 + ks) * 8) * 512, 1024, scr, F.lane); continue; } r -= I_D;
        p0_router_item(F, r);
    }
    PSTAMP(32);
    if (F.tid == 0) { unsigned sp = 0; while (__hip_atomic_load(F.ctl + CW_ADACNT, RLX_AGENT) < (unsigned)N_ADA_ITEMS) { __builtin_amdgcn_s_sleep(2); if (++sp > (1u << 22)) break; }
        __builtin_amdgcn_fence(__ATOMIC_ACQUIRE, "agent"); VM_WAIT(); }
    __syncthreads();
    PSTAMP(33);
    const float* ada = (const float*)(F.ws + WS_ADA); bf16* HX = (bf16*)(F.ws + WS_HX);
    LAS float* tb = (LAS float*)F.lds;
#pragma unroll
    for (int i = 0; i < 4; ++i) { const int idx = F.tid + NTHR * i, b = idx >> 9, v = (idx >> 8) & 1, c4 = idx & 255;
        f32x4 val = ada4(ada + b * 6 * D + v * D + 4 * c4); if (v) val = val + 1.f;
        *(LAS f32x4*)(tb + (size_t)idx * 4) = val; }
    __syncthreads();
    for (;;) {
        if (F.tid == 0) *bc = (int)__hip_atomic_fetch_add(F.ctl + CW_WORK1, 1u, RLX_AGENT);
        __syncthreads();
        const int grp = *bc;
        __syncthreads();
        if (grp >= T / 32) break;
        const int m = grp * 32 + F.wave * 4, b = m / SEQ;
        f32x4 xv[4][4];
#pragma unroll
        for (int r = 0; r < 4; ++r) { const f32x4* xr = (const f32x4*)(F.x + (size_t)(m + r) * D) + F.lane;
#pragma unroll
            for (int j = 0; j < 4; ++j) xv[r][j] = xr[64 * j]; }
        f32x4 sh[4], sc[4];
#pragma unroll
        for (int j = 0; j < 4; ++j) { sh[j] = *(const LAS f32x4*)(tb + b * 2048 + 256 * j + 4 * F.lane); sc[j] = *(const LAS f32x4*)(tb + b * 2048 + 1024 + 256 * j + 4 * F.lane); }
#pragma unroll
        for (int r = 0; r < 4; ++r) { unsigned long long* o8 = (unsigned long long*)(HX + (size_t)(m + r) * D) + F.lane;
#pragma unroll
            for (int j = 0; j < 4; ++j) { const f32x4 h = xv[r][j] * sc[j] + sh[j];
                o8[64 * j] = (unsigned long long)pk2(h.x, h.y) | ((unsigned long long)pk2(h.z, h.w) << 32); } }
    }
    PSTAMP(34);
}
constexpr int A_STRIDE = 1040;
constexpr int P3_AATT = 0, P3_ACONV = 64 * A_STRIDE;
constexpr int H_STRIDE = 2064;
constexpr int P3_LG = 2 * 64 * A_STRIDE;
constexpr int P3_RED = P3_LG + 24576;
constexpr int P3_END = P3_RED + 4096;
static_assert(P3_END + 256 <= LDS_BYTES && 64 * H_STRIDE <= P3_LG, "P3 LDS map");

__device__ __forceinline__ int crow(int r, int hi) { return (r & 3) + 8 * (r >> 2) + 4 * hi; }

__device__ __forceinline__ void sb_scan(f32x16& x, float& P, bool diag, int keybase, int t, int hi, int lane) {
    float r[16], s[16], Tg[4], U[4];
#pragma unroll
    for (int i = 0; i < 16; ++i) { const float e = __builtin_amdgcn_exp2f(x[i]); r[i] = __builtin_amdgcn_rcpf(1.f + e); }
    if (diag) {
#pragma unroll
        for (int i = 0; i < 16; ++i) { const int key = keybase + crow(i, hi); r[i] = key >= t ? 1.f : r[i]; }
    }
#pragma unroll
    for (int g = 0; g < 4; ++g) { const int b = 4 * g; s[b + 3] = 1.f; s[b + 2] = r[b + 3]; s[b + 1] = s[b + 2] * r[b + 2]; s[b] = s[b + 1] * r[b + 1]; Tg[g] = s[b] * r[b]; }
#pragma unroll
    for (int g = 0; g < 4; ++g) U[g] = shx(Tg[g], 32, lane);
    const float W0 = Tg[0] * U[0], W1 = Tg[1] * U[1], W2 = Tg[2] * U[2], W3 = Tg[3] * U[3];
    float S[4]; S[3] = 1.f; S[2] = W3; S[1] = W3 * W2; S[0] = S[1] * W1;
    const float tot = S[0] * W0;
    float Fg[4];
#pragma unroll
    for (int g = 0; g < 4; ++g) Fg[g] = S[g] * (hi ? 1.f : U[g]) * P;
#pragma unroll
    for (int i = 0; i < 16; ++i) x[i] = (1.f - r[i]) * (s[i] * Fg[i >> 2]);
    P *= tot;
}
__device__ __forceinline__ void pv64(f32x16& o0, f32x16& o1, int vb, bf16x8 pa0, bf16x8 pa1, bf16x8 pa2, bf16x8 pa3) {
#define PK(k) (bf16x8){lo[k][0], lo[k][1], lo[k][2], lo[k][3], hi[k][0], hi[k][1], hi[k][2], hi[k][3]}
    { s16x4 lo[4], hi[4];
#pragma unroll
      for (int ks = 0; ks < 4; ++ks) {
          asm volatile("ds_read_b64_tr_b16 %0,%1 offset:%c2" : "=&v"(lo[ks]) : "v"(vb), "i"(ks * 1024) : "memory");
          asm volatile("ds_read_b64_tr_b16 %0,%1 offset:%c2" : "=&v"(hi[ks]) : "v"(vb), "i"(ks * 1024 + 512) : "memory"); }
      asm volatile("s_waitcnt lgkmcnt(0)" ::: "memory"); __builtin_amdgcn_sched_barrier(0);
      o0 = __builtin_amdgcn_mfma_f32_32x32x16_bf16(pa0, PK(0), o0, 0, 0, 0); o0 = __builtin_amdgcn_mfma_f32_32x32x16_bf16(pa1, PK(1), o0, 0, 0, 0);
      o0 = __builtin_amdgcn_mfma_f32_32x32x16_bf16(pa2, PK(2), o0, 0, 0, 0); o0 = __builtin_amdgcn_mfma_f32_32x32x16_bf16(pa3, PK(3), o0, 0, 0, 0); }
    { s16x4 lo[4], hi[4];
#pragma unroll
      for (int ks = 0; ks < 4; ++ks) {
          asm volatile("ds_read_b64_tr_b16 %0,%1 offset:%c2" : "=&v"(lo[ks]) : "v"(vb), "i"(4096 + ks * 1024) : "memory");
          asm volatile("ds_read_b64_tr_b16 %0,%1 offset:%c2" : "=&v"(hi[ks]) : "v"(vb), "i"(4096 + ks * 1024 + 512) : "memory"); }
      asm volatile("s_waitcnt lgkmcnt(0)" ::: "memory"); __builtin_amdgcn_sched_barrier(0);
      o1 = __builtin_amdgcn_mfma_f32_32x32x16_bf16(pa0, PK(0), o1, 0, 0, 0); o1 = __builtin_amdgcn_mfma_f32_32x32x16_bf16(pa1, PK(1), o1, 0, 0, 0);
      o1 = __builtin_amdgcn_mfma_f32_32x32x16_bf16(pa2, PK(2), o1, 0, 0, 0); o1 = __builtin_amdgcn_mfma_f32_32x32x16_bf16(pa3, PK(3), o1, 0, 0, 0); }
#undef PK
}
__device__ __forceinline__ void attn_unit(const bf16* PROJ, int b, int h, int q0, LAS unsigned char* vst, LAS unsigned char* aatt, int arow0, int lane) {
    const int r32 = lane & 31, hi = lane >> 5;
    const size_t rowb = (size_t)b * SEQ;
    bf16x8 qr[4];
    { const bf16* qp = PROJ + (rowb + q0 + r32) * DPROJ + h * HD + hi * 8;
#pragma unroll
      for (int ks = 0; ks < 4; ++ks) qr[ks] = *(const bf16x8*)(qp + ks * 16); }
    f32x16 o0, o1;
#pragma unroll
    for (int i = 0; i < 16; ++i) { o0[i] = 0.f; o1[i] = 0.f; }
    float P = 1.f;
    const int t = q0 + r32;
    const int vb = (int)(unsigned)(uintptr_t)vst + ((lane >> 4) & 1) * 32 + (lane & 3) * 8 + (4 * hi + ((lane & 15) >> 2)) * 64;
    for (int jb = (q0 + 31) >> 6; jb >= 0; --jb) {
        const int kb0 = jb * 64;
        bf16x8 k0[4], k1[4];
        { const bf16* kp = PROJ + (rowb + kb0 + r32) * DPROJ + DATT + h * HD + hi * 8;
#pragma unroll
          for (int ks = 0; ks < 4; ++ks) { k0[ks] = *(const bf16x8*)(kp + ks * 16); k1[ks] = *(const bf16x8*)(kp + (size_t)32 * DPROJ + ks * 16); } }
        v4u vv[8];
#pragma unroll
        for (int i = 0; i < 8; ++i) { const int p = i * 64 + lane, key = p >> 3, c = p & 7; vv[i] = *(const v4u*)(PROJ + (rowb + kb0 + key) * DPROJ + 2 * DATT + h * HD + c * 8); }
#pragma unroll
        for (int i = 0; i < 8; ++i) { const int p = i * 64 + lane, key = p >> 3, c = p & 7; *(LAS v4u*)(vst + (c >> 2) * 4096 + key * 64 + (c & 3) * 16) = vv[i]; }
        f32x16 p0, p1;
#pragma unroll
        for (int i = 0; i < 16; ++i) { p0[i] = 0.f; p1[i] = 0.f; }
#pragma unroll
        for (int ks = 0; ks < 4; ++ks) { p0 = __builtin_amdgcn_mfma_f32_32x32x16_bf16(k0[ks], qr[ks], p0, 0, 0, 0); p1 = __builtin_amdgcn_mfma_f32_32x32x16_bf16(k1[ks], qr[ks], p1, 0, 0, 0); }
        const bool diag = (kb0 + 63 >= q0);
        sb_scan(p1, P, diag, kb0 + 32, t, hi, lane);
        sb_scan(p0, P, diag, kb0, t, hi, lane);
        v4u pw0, pw1, pw2, pw3;
        pw0 = (v4u){pk2(p0[0], p0[1]), pk2(p0[2], p0[3]), pk2(p0[4], p0[5]), pk2(p0[6], p0[7])};
        pw1 = (v4u){pk2(p0[8], p0[9]), pk2(p0[10], p0[11]), pk2(p0[12], p0[13]), pk2(p0[14], p0[15])};
        pw2 = (v4u){pk2(p1[0], p1[1]), pk2(p1[2], p1[3]), pk2(p1[4], p1[5]), pk2(p1[6], p1[7])};
        pw3 = (v4u){pk2(p1[8], p1[9]), pk2(p1[10], p1[11]), pk2(p1[12], p1[13]), pk2(p1[14], p1[15])};
        LDS_WAIT();
        pv64(o0, o1, vb, __builtin_bit_cast(bf16x8, pw0), __builtin_bit_cast(bf16x8, pw1), __builtin_bit_cast(bf16x8, pw2), __builtin_bit_cast(bf16x8, pw3));
        if (__all(P < P_STOP)) break;
    }
#pragma unroll
    for (int r = 0; r < 16; ++r) { LAS unsigned short* dst = (LAS unsigned short*)(aatt + (arow0 + crow(r, hi)) * A_STRIDE + (h * HD + r32) * 2);
        dst[0] = (unsigned short)(pk2(o0[r], 0.f) & 0xffffu); dst[32] = (unsigned short)(pk2(o1[r], 0.f) & 0xffffu); }
}
template <int MT>
__device__ __forceinline__ void row_stats(const f32x4 (&v)[MT][8], LAS float* red, int w, int lane, float (&mean)[MT], float (&rstd)[MT]) {
    const int fr = lane & 15, fq = lane >> 4;
#pragma unroll
    for (int mt = 0; mt < MT; ++mt) { float s = 0.f;
#pragma unroll
        for (int nt = 0; nt < 8; ++nt) s += (v[mt][nt][0] + v[mt][nt][1]) + (v[mt][nt][2] + v[mt][nt][3]);
        s += shx(s, 16, lane); s += shx(s, 32, lane);
        if (fq == 0) red[w * 64 + 16 * mt + fr] = s; }
    LBAR();
#pragma unroll
    for (int mt = 0; mt < MT; ++mt) { float s = 0.f;
#pragma unroll
        for (int ww = 0; ww < 8; ++ww) s += red[ww * 64 + 16 * mt + fr];
        mean[mt] = s * (1.f / D); }
#pragma unroll
    for (int mt = 0; mt < MT; ++mt) { float q = 0.f;
#pragma unroll
        for (int nt = 0; nt < 8; ++nt) { const f32x4 d = v[mt][nt] - mean[mt]; q += (d[0] * d[0] + d[1] * d[1]) + (d[2] * d[2] + d[3] * d[3]); }
        q += shx(q, 16, lane); q += shx(q, 32, lane);
        if (fq == 0) red[512 + w * 64 + 16 * mt + fr] = q; }
    LBAR();
#pragma unroll
    for (int mt = 0; mt < MT; ++mt) { float q = 0.f;
#pragma unroll
        for (int ww = 0; ww < 8; ++ww) q += red[512 + ww * 64 + 16 * mt + fr];
        rstd[mt] = 1.f / sqrtf(q * (1.f / D) + LN_EPS); }
}

template <int NKS, int BSTRIDE, int NACC, int NT0, int MT, int NBUF = 4>
__device__ __forceinline__ void panel_gemm(f32x4 (&acc)[MT][NACC], const LAS unsigned char* a0, int astride, const unsigned char* bp) {
    static_assert(NKS % NBUF == 0 && NKS >= NBUF && (NBUF == 4 || NBUF == 8), "k-steps in groups of NBUF");
    bf16x8 B[NBUF][4], Af[MT];
#pragma unroll
    for (int u = 0; u < NBUF - 1; ++u)
#pragma unroll
        for (int nt = 0; nt < 4; ++nt) { B[u][nt] = *(const bf16x8*)(bp + u * BSTRIDE + nt * 1024); __builtin_amdgcn_sched_barrier(0); }
#pragma unroll 1
    for (int ks = 0; ks < NKS; ks += NBUF) {
#pragma unroll
        for (int u = 0; u < NBUF; ++u) {
            const int kl = ks + u + NBUF - 1;
            const unsigned char* bl = bp + (size_t)(kl < NKS ? kl : NKS - 1) * BSTRIDE;
#pragma unroll
            for (int nt = 0; nt < 4; ++nt) { B[(u + NBUF - 1) % NBUF][nt] = *(const bf16x8*)(bl + nt * 1024); __builtin_amdgcn_sched_barrier(0); }
#pragma unroll
            for (int mt = 0; mt < MT; ++mt) Af[mt] = *(const LAS bf16x8*)(a0 + mt * 16 * astride + (ks + u) * 64);
            __builtin_amdgcn_sched_barrier(0);
#pragma unroll
            for (int nt = 0; nt < 4; ++nt)
#pragma unroll
                for (int mt = 0; mt < MT; ++mt) acc[mt][NT0 + nt] = __builtin_amdgcn_mfma_f32_16x16x32_bf16(B[u][nt], Af[mt], acc[mt][NT0 + nt], 0, 0, 0);
            __builtin_amdgcn_sched_barrier(0);
        }
    }
}

__device__ __forceinline__ void p3_panel(Frame& F, int tile) {
    const int m0 = tile * 64, b = m0 / SEQ, t0 = m0 % SEQ;
    const int w = F.wave;
    const bf16* PROJ = (const bf16*)(F.ws + WS_PROJ);
    const float* ada = (const float*)(F.ws + WS_ADA) + b * 6 * D;
    LAS unsigned char* lds = F.lds;
    PSTAMP(20);
    { const int tid = w * 64 + lane_now();
#pragma unroll
      for (int i = 0; i < 3; ++i) { const int idx = tid + NTHR * i; if (idx < 1280) { const int v = idx >> 8, c = 4 * (idx & 255);
          f32x4 val; if (v == 1) val = *(const f32x4*)(F.ln1_g + c); else if (v == 2) val = *(const f32x4*)(F.ln1_b + c); else val = ada4(ada + (v == 0 ? 2 * D : (v == 3 ? 4 * D : 3 * D)) + c);
          *(LAS f32x4*)(lds + P3_LG + idx * 16) = val; } } }
    attn_unit(PROJ, b, w, t0, lds + P3_ACONV + w * 8192, lds + P3_AATT, 0, lane_now());
    attn_unit(PROJ, b, w, t0 + 32, lds + P3_ACONV + w * 8192, lds + P3_AATT, 32, lane_now());
    LBAR();
    PSTAMP(21);
    { const int tid = w * 64 + lane_now(), ch = tid & 63;
      f32x4 cw[3][2];
#pragma unroll
      for (int kk = 0; kk < 3; ++kk) { cw[kk][0] = *(const f32x4*)(F.conv_w + kk * DCONV + 8 * ch); cw[kk][1] = *(const f32x4*)(F.conv_w + kk * DCONV + 8 * ch + 4); }
#pragma unroll 1
      for (int hb = 0; hb < 2; ++hb) { v4u cb[4], cc[4][3], cx[4][3];
#pragma unroll
          for (int q = 0; q < 4; ++q) { const int row = ((hb * 4 + q) * NTHR + tid) >> 6, t = t0 + row; const bf16* base = PROJ + (size_t)(m0 + row) * DPROJ + 8 * ch;
              cb[q] = *(const v4u*)(base + 1536);
#pragma unroll
              for (int kk = 0; kk < 3; ++kk) { const bool ok = (t - 2 + kk >= 0); const bf16* rp = ok ? base - (size_t)(2 - kk) * DPROJ : base;
                  cc[q][kk] = *(const v4u*)(rp + 2048); cx[q][kk] = *(const v4u*)(rp + 2560); if (!ok) cc[q][kk] = (v4u){0u, 0u, 0u, 0u}; } }
#pragma unroll
          for (int q = 0; q < 4; ++q) { const int row = ((hb * 4 + q) * NTHR + tid) >> 6; float y[8];
#pragma unroll
              for (int jj = 0; jj < 8; ++jj) y[jj] = 0.f;
#pragma unroll
              for (int kk = 0; kk < 3; ++kk) { const v4u c1 = cc[q][kk], c2 = cx[q][kk]; const f32x4 w0 = cw[kk][0], w1 = cw[kk][1];
                  y[0] += w0[0] * bflo(c1.x) * bflo(c2.x); y[1] += w0[1] * bfhi(c1.x) * bfhi(c2.x); y[2] += w0[2] * bflo(c1.y) * bflo(c2.y); y[3] += w0[3] * bfhi(c1.y) * bfhi(c2.y);
                  y[4] += w1[0] * bflo(c1.z) * bflo(c2.z); y[5] += w1[1] * bfhi(c1.z) * bfhi(c2.z); y[6] += w1[2] * bflo(c1.w) * bflo(c2.w); y[7] += w1[3] * bfhi(c1.w) * bfhi(c2.w); }
              const v4u b4 = cb[q]; v4u o; o.x = pk2(bflo(b4.x) * y[0], bfhi(b4.x) * y[1]); o.y = pk2(bflo(b4.y) * y[2], bfhi(b4.y) * y[3]); o.z = pk2(bflo(b4.z) * y[4], bfhi(b4.z) * y[5]); o.w = pk2(bflo(b4.w) * y[6], bfhi(b4.w) * y[7]);
              *(LAS v4u*)(lds + P3_ACONV + row * A_STRIDE + ch * 16) = o; } } }
    LBAR();
    PSTAMP(22);
    const int lane = lane_now(), fr = lane & 15, fq = lane >> 4;
    f32x4 acc[4][8];
#pragma unroll
    for (int mt = 0; mt < 4; ++mt)
#pragma unroll
        for (int nt = 0; nt < 8; ++nt) acc[mt][nt] = (f32x4){0.f, 0.f, 0.f, 0.f};
    const unsigned char* bp = F.ws + WS_WOUT + (size_t)w * 32 * 8192 + lane * 16;
    panel_gemm<16, 8192, 8, 0, 4>(acc, lds + P3_AATT + fr * A_STRIDE + fq * 16, A_STRIDE, bp);
    panel_gemm<16, 8192, 8, 0, 4>(acc, lds + P3_ACONV + fr * A_STRIDE + fq * 16, A_STRIDE, bp + 16 * 8192);
    panel_gemm<16, 8192, 8, 4, 4>(acc, lds + P3_AATT + fr * A_STRIDE + fq * 16, A_STRIDE, bp + 4096);
    panel_gemm<16, 8192, 8, 4, 4>(acc, lds + P3_ACONV + fr * A_STRIDE + fq * 16, A_STRIDE, bp + 16 * 8192 + 4096);
    PSTAMP(23);
    const LAS float* tab = (const LAS float*)(lds + P3_LG);
    const int colw = 128 * w + 4 * fq;
    { f32x4 xv[4][8];
#define P3_LOADG(m) do { const float* xp_ = F.x + (size_t)(m0 + 16 * (m) + fr) * D + colw; _Pragma("unroll") for (int nt = 0; nt < 8; ++nt) xv[m][nt] = *(const f32x4*)(xp_ + 16 * nt); } while (0)
#define P3_COMP(m) do { _Pragma("unroll") for (int nt = 0; nt < 8; ++nt) acc[m][nt] = ALPHA * xv[m][nt] + *(const LAS f32x4*)(tab + colw + 16 * nt) * acc[m][nt]; \
        asm volatile("" : "+v"(acc[m][0]), "+v"(acc[m][1]), "+v"(acc[m][2]), "+v"(acc[m][3]), "+v"(acc[m][4]), "+v"(acc[m][5]), "+v"(acc[m][6]), "+v"(acc[m][7]) :: "memory"); } while (0)
      P3_LOADG(0); P3_LOADG(1); P3_COMP(0); P3_LOADG(2); P3_COMP(1); P3_LOADG(3); P3_COMP(2); P3_COMP(3);
#undef P3_LOADG
#undef P3_COMP
    }
    float mean[4], rstd[4];
    row_stats<4>(acc, (LAS float*)(lds + P3_RED), w, lane, mean, rstd);
#pragma unroll
    for (int nt = 0; nt < 8; ++nt) { const int col = colw + 16 * nt;
        const f32x4 g = *(const LAS f32x4*)(tab + 1024 + col), be = *(const LAS f32x4*)(tab + 2048 + col), s2 = *(const LAS f32x4*)(tab + 3072 + col), h2s = *(const LAS f32x4*)(tab + 4096 + col);
#pragma unroll
        for (int mt = 0; mt < 4; ++mt) { const f32x4 x1 = (acc[mt][nt] - mean[mt]) * rstd[mt] * g + be;
            const f32x4 h2 = x1 * (1.f + s2) + h2s;
            v2u pk; pk.x = pk2(h2[0], h2[1]); pk.y = pk2(h2[2], h2[3]);
            *(LAS v2u*)(lds + (16 * mt + fr) * H_STRIDE + col * 2) = pk; } }
    LBAR();
    PSTAMP(24);
    { const int mt = w >> 1, kh = w & 1; const int lane = lane_now(), fr = lane & 15, fq = lane >> 4;
      f32x4 rl[3];
#pragma unroll
      for (int nt = 0; nt < 3; ++nt) rl[nt] = (f32x4){0.f, 0.f, 0.f, 0.f};
      const unsigned char* wr = F.ws + WS_WR + lane * 16;
#pragma unroll 8
      for (int ks = 16 * kh; ks < 16 * kh + 16; ++ks) { const bf16x8 af = *(const LAS bf16x8*)(lds + (16 * mt + fr) * H_STRIDE + ks * 64 + fq * 16);
#pragma unroll
          for (int nt = 0; nt < 3; ++nt) { const bf16x8 bf = *(const bf16x8*)(wr + (size_t)(ks * 3 + nt) * 1024); rl[nt] = __builtin_amdgcn_mfma_f32_16x16x32_bf16(bf, af, rl[nt], 0, 0, 0); } }
      LAS float* lg = (LAS float*)(lds + P3_LG) + kh * (64 * 48) + (16 * mt + fr) * 48 + 4 * fq;
#pragma unroll
      for (int nt = 0; nt < 3; ++nt) *(LAS f32x4*)(lg + 16 * nt) = rl[nt]; }
    LBAR();
    PSTAMP(25);
    if (w == 0) { const int lane = lane_now(); const LAS float* l0 = (const LAS float*)(lds + P3_LG) + lane * 48; const LAS float* l1 = l0 + 64 * 48;
        float gl[4]; int gi = 0;
#pragma unroll
        for (int j = 0; j < 4; ++j) gl[j] = l0[j] + l1[j] + F.brg[j];
        float gm = gl[0];
#pragma unroll
        for (int j = 1; j < 4; ++j) if (gl[j] > gm) { gm = gl[j]; gi = j; }
        float gs = 0.f;
#pragma unroll
        for (int j = 0; j < 4; ++j) gs += expf(gl[j] - gm);
        const float gprob = 1.f / gs;
        float el[8];
#pragma unroll
        for (int j = 0; j < 8; ++j) el[j] = l0[4 + gi * 8 + j] + l1[4 + gi * 8 + j] + F.bre[gi * 8 + j];
        int i1 = 0; float m1 = el[0];
#pragma unroll
        for (int j = 1; j < 8; ++j) if (el[j] > m1) { m1 = el[j]; i1 = j; }
        int i2 = -1; float m2 = -3.0e38f;
#pragma unroll
        for (int j = 0; j < 8; ++j) if (j != i1 && el[j] > m2) { m2 = el[j]; i2 = j; }
        const float w1 = 1.f / (1.f + expf(m2 - m1)), w2 = 1.f - w1;
        const int ea = i1 < i2 ? i1 : i2, eb = i1 < i2 ? i2 : i1;
        const float wa = (i1 < i2 ? w1 : w2) * gprob, wb = (i1 < i2 ? w2 : w1) * gprob;
        const int m = m0 + lane;
        ((int*)(F.ws + WS_RC))[m] = gi * 28 + (ea * (15 - ea)) / 2 + (eb - ea - 1);
        *(f32x2*)((float*)(F.ws + WS_RW) + 2 * m) = (f32x2){wa, wb};
        ((int*)(F.ws + WS_RE))[2 * m] = gi * 8 + ea; ((int*)(F.ws + WS_RE))[2 * m + 1] = gi * 8 + eb;
    }
    { bf16* H2 = (bf16*)(F.ws + WS_H2); const int tid = w * 64 + lane_now();
#pragma unroll
      for (int i = 0; i < 16; ++i) { const int p = i * NTHR + tid, row = p >> 7, ch = p & 127;
          const v4u v = *(const LAS v4u*)(lds + row * H_STRIDE + ch * 16); *(v4u*)(H2 + (size_t)(m0 + row) * D + ch * 8) = v; } }
    LBAR();
    PSTAMP(26);
}
constexpr int P4_A = 0;
constexpr int P4_TAB = 64 * A_STRIDE;
constexpr int P4_RED = 64 * H_STRIDE;
constexpr int P4_TOK = P4_RED + 4096;
constexpr int P4_RW = P4_TOK + 256;
constexpr int P4_HIST = P4_RW + 512;
constexpr int P4_TSTART = P4_HIST + 512;
constexpr int P4_WSUM = P4_TSTART + 512;
constexpr int P4_TLIST = P4_WSUM + 64;
constexpr int P4_CID = P4_TLIST + 1024;
constexpr int P4_END = P4_CID + T;
static_assert(P4_END + 256 <= LDS_BYTES, "P4 LDS map");

template <int MT>
__device__ __forceinline__ void p4_tile(Frame& F, int combo, int n  , int pofs) {
    const int w = F.wave;
    LAS unsigned char* lds = F.lds;
    const LAS int* tok = (const LAS int*)(lds + P4_TOK);
    const LAS float* rw = (const LAS float*)(lds + P4_RW);
    const int g = combo / 28, pi = combo % 28;
    int ea = 0, rem = pi; while (rem >= 7 - ea) { rem -= 7 - ea; ++ea; }
    const int eb = ea + 1 + rem;
    const int ex[2] = {g * 8 + ea, g * 8 + eb};
    { const bf16* H2 = (const bf16*)(F.ws + WS_H2); const int tid = w * 64 + lane_now();
#pragma unroll
      for (int hh = 0; hh < MT / 2; ++hh) { int tk8[8]; v4u gv[8];
#pragma unroll
          for (int i = 0; i < 8; ++i) tk8[i] = tok[((hh * 8 + i) * NTHR + tid) >> 7];
#pragma unroll
          for (int i = 0; i < 8; ++i) gv[i] = *(const v4u*)(H2 + (size_t)tk8[i] * D + (tid & 127) * 8);
#pragma unroll
          for (int i = 0; i < 8; ++i) *(LAS v4u*)(lds + P4_A + (((hh * 8 + i) * NTHR + tid) >> 7) * H_STRIDE + (tid & 127) * 16) = gv[i]; } }
    LBAR();
    PSTAMP(6 + pofs);
    unsigned hp[2][MT][2][2];
#pragma unroll
    for (int s = 0; s < 2; ++s) { const int lane = lane_now(), fr = lane & 15, fq = lane >> 4;
        f32x4 a1[MT][4];
#pragma unroll
        for (int mt = 0; mt < MT; ++mt)
#pragma unroll
            for (int nt = 0; nt < 4; ++nt) a1[mt][nt] = (f32x4){0.f, 0.f, 0.f, 0.f};
        const int e = s ? ex[1] : ex[0];
        panel_gemm<32, 4096, 4, 0, MT>(a1, lds + P4_A + fr * H_STRIDE + fq * 16, H_STRIDE, F.ws + WS_WGU + (size_t)(e * 8 + w) * 32 * 4096 + lane * 16);
#pragma unroll
        for (int mt = 0; mt < MT; ++mt) { const float cw = rw[(16 * mt + fr) * 2 + s];
#pragma unroll
            for (int nt = 0; nt < 2; ++nt) { const f32x4 gv = a1[mt][nt], uv = a1[mt][2 + nt]; float hv[4];
#pragma unroll
                for (int j = 0; j < 4; ++j) { const float sg = gv[j] * __builtin_amdgcn_rcpf(1.f + __builtin_amdgcn_exp2f(-1.4426950408889634f * gv[j])); hv[j] = sg * uv[j] * cw; }
                hp[s][mt][nt][0] = pk2(hv[0], hv[1]); hp[s][mt][nt][1] = pk2(hv[2], hv[3]); } }
    }
    PSTAMP(7 + pofs);
    LBAR();
    const int lane = lane_now(), fr = lane & 15, fq = lane >> 4;
#pragma unroll
    for (int s = 0; s < 2; ++s)
#pragma unroll
        for (int mt = 0; mt < MT; ++mt)
#pragma unroll
            for (int nt = 0; nt < 2; ++nt) { v2u pk; pk.x = hp[s][mt][nt][0]; pk.y = hp[s][mt][nt][1];
                *(LAS v2u*)(lds + P4_A + (16 * mt + fr) * A_STRIDE + (s * 256 + 32 * w + 16 * nt + 4 * fq) * 2) = pk; }
    { const float* ada = (const float*)(F.ws + WS_ADA); const int tid = w * 64 + lane;
#pragma unroll
      for (int i = 0; i < 7; ++i) { const int idx = tid + NTHR * i;
          f32x4 v;
          if (idx < 1024) v = ada4(ada + (idx >> 8) * 6 * D + 5 * D + 4 * (idx & 255));
          else if (idx < 1536) v = *(const f32x4*)(idx < 1280 ? F.ln2_g + 4 * (idx - 1024) : F.ln2_b + 4 * (idx - 1280));
          else if (idx < 2560) { const f32x4 sc = ada4(ada + ((idx - 1536) >> 8) * 6 * D + 4 * D + 4 * (idx & 255)); v = (f32x4){1.f / (1.f + sc[0]), 1.f / (1.f + sc[1]), 1.f / (1.f + sc[2]), 1.f / (1.f + sc[3])}; }
          else v = ada4(ada + ((idx - 2560) >> 8) * 6 * D + 3 * D + 4 * (idx & 255));
          *(LAS f32x4*)(lds + P4_TAB + idx * 16) = v; } }
    LBAR();
    PSTAMP(8 + pofs);
    f32x4 acc[MT][8];
#pragma unroll
    for (int mt = 0; mt < MT; ++mt)
#pragma unroll
        for (int nt = 0; nt < 8; ++nt) acc[mt][nt] = (f32x4){0.f, 0.f, 0.f, 0.f};
    { const unsigned char* b0 = F.ws + WS_WD + (size_t)(ex[0] * 8 + w) * 8 * 8192 + lane * 16; const unsigned char* b1 = F.ws + WS_WD + (size_t)(ex[1] * 8 + w) * 8 * 8192 + lane * 16;
      const LAS unsigned char* ha = lds + P4_A + fr * A_STRIDE + fq * 16;
      panel_gemm<8, 8192, 8, 0, MT>(acc, ha, A_STRIDE, b0); panel_gemm<8, 8192, 8, 0, MT>(acc, ha + 512, A_STRIDE, b1);
      panel_gemm<8, 8192, 8, 4, MT>(acc, ha, A_STRIDE, b0 + 4096); panel_gemm<8, 8192, 8, 4, MT>(acc, ha + 512, A_STRIDE, b1 + 4096); }
    PSTAMP(9 + pofs);
    const LAS float* tab = (const LAS float*)(lds + P4_TAB);
    const int colw = 128 * w + 4 * fq;
    int tk[MT];
#pragma unroll
    for (int mt = 0; mt < MT; ++mt) tk[mt] = tok[16 * mt + fr];
    v2u xv[MT][8]; const bf16* H2g = (const bf16*)(F.ws + WS_H2);
#define P4_LOADG(m) do { const bf16* xp_ = H2g + (size_t)tk[m] * D + colw; _Pragma("unroll") for (int nt = 0; nt < 8; ++nt) xv[m][nt] = *(const v2u*)(xp_ + 16 * nt); } while (0)
#define P4_COMP(m) do { const LAS float* g_ = tab + (tk[m] / SEQ) * 1024 + colw; _Pragma("unroll") for (int nt = 0; nt < 8; ++nt) { const v2u hv_ = xv[m][nt]; const f32x4 h2_ = (f32x4){bflo(hv_.x), bfhi(hv_.x), bflo(hv_.y), bfhi(hv_.y)}; \
            const f32x4 x1_ = (h2_ - *(const LAS f32x4*)(g_ + 10240 + 16 * nt)) * *(const LAS f32x4*)(g_ + 6144 + 16 * nt); acc[m][nt] = ALPHA * x1_ + *(const LAS f32x4*)(g_ + 16 * nt) * acc[m][nt]; } \
        asm volatile("" : "+v"(acc[m][0]), "+v"(acc[m][1]), "+v"(acc[m][2]), "+v"(acc[m][3]), "+v"(acc[m][4]), "+v"(acc[m][5]), "+v"(acc[m][6]), "+v"(acc[m][7]) :: "memory"); } while (0)
    P4_LOADG(0); P4_LOADG(1); if constexpr (MT == 4) { P4_LOADG(2); P4_LOADG(3); } P4_COMP(0); P4_COMP(1); if constexpr (MT == 4) { P4_COMP(2); P4_COMP(3); }
#undef P4_LOADG
#undef P4_COMP
    float mean[MT], rstd[MT];
    row_stats<MT>(acc, (LAS float*)(lds + P4_RED), w, lane, mean, rstd);
#pragma unroll
    for (int nt = 0; nt < 8; ++nt) { const int col = colw + 16 * nt; const f32x4 gg = *(const LAS f32x4*)(tab + 4096 + col), be = *(const LAS f32x4*)(tab + 5120 + col);
#pragma unroll
        for (int mt = 0; mt < MT; ++mt) if (16 * mt + fr < n) *(f32x4*)(F.out + (size_t)tk[mt] * D + col) = (acc[mt][nt] - mean[mt]) * rstd[mt] * gg + be; }
    LBAR();
}

__device__ __forceinline__ void p4_moe(Frame& F) {
    LAS unsigned char* lds = F.lds;
    LAS int* hist = (LAS int*)(lds + P4_HIST); LAS int* wsum = (LAS int*)(lds + P4_WSUM);
    LAS int* tok = (LAS int*)(lds + P4_TOK); LAS float* rwl = (LAS float*)(lds + P4_RW);
    LAS unsigned short* tlist = (LAS unsigned short*)(lds + P4_TLIST);
    LAS int* misc = (LAS int*)(lds + P4_TSTART);
    const int* RC = (const int*)(F.ws + WS_RC); const float* RW = (const float*)(F.ws + WS_RW);
    { const int tid0 = F.wave * 64 + lane_now(); if (tid0 < 128) hist[tid0] = 0; }
    LBAR();
    { const int tid = F.wave * 64 + lane_now(); LAS unsigned char* cidp = lds + P4_CID + 32 * tid;
      unsigned pw[8];
#pragma unroll
      for (int i = 0; i < 8; ++i) { const v4u v = *(const v4u*)(RC + 32 * tid + 4 * i);
          __hip_atomic_fetch_add(&hist[v.x], 1, __ATOMIC_RELAXED, __HIP_MEMORY_SCOPE_WORKGROUP); __hip_atomic_fetch_add(&hist[v.y], 1, __ATOMIC_RELAXED, __HIP_MEMORY_SCOPE_WORKGROUP); __hip_atomic_fetch_add(&hist[v.z], 1, __ATOMIC_RELAXED, __HIP_MEMORY_SCOPE_WORKGROUP); __hip_atomic_fetch_add(&hist[v.w], 1, __ATOMIC_RELAXED, __HIP_MEMORY_SCOPE_WORKGROUP);
          pw[i] = (v.x & 0xffu) | ((v.y & 0xffu) << 8) | ((v.z & 0xffu) << 16) | ((v.w & 0xffu) << 24); }
      *(LAS v4u*)(cidp) = (v4u){pw[0], pw[1], pw[2], pw[3]}; *(LAS v4u*)(cidp + 16) = (v4u){pw[4], pw[5], pw[6], pw[7]}; }
    LBAR();
    { const int c = F.wave * 64 + lane_now();
      if (c < NCOMBO) { const int nc = hist[c], fc = nc >> 6, rc = nc & 63; int fbefore = 0, ftotal = 0, pos = 0;
          for (int c2 = 0; c2 < NCOMBO; ++c2) { const int n2 = hist[c2], f2 = n2 >> 6, r2 = n2 & 63; ftotal += f2; if (c2 < c) fbefore += f2; if (r2 > rc || (r2 == rc && c2 < c)) pos += (r2 > 0) ? 1 : 0; }
          for (int j = 0; j < fc; ++j) tlist[fbefore + j] = (unsigned short)(c | (j << 8));
          if (rc > 0) tlist[ftotal + pos] = (unsigned short)(c | (fc << 8));
          if (c == 0) { int np = 0; for (int c2 = 0; c2 < NCOMBO; ++c2) np += (hist[c2] & 63) ? 1 : 0; misc[0] = ftotal; misc[1] = ftotal + np; } } }
    LBAR();
    const int ntile = misc[1];
    PSTAMP(4);
    for (int round = 0; round * F.G < ntile; ++round) {
        const int tile = round * F.G + ((round & 1) ? (F.G - 1 - F.vcu) : F.vcu);
        if (tile >= ntile) break;
        const int lane = lane_now(), tid = F.wave * 64 + lane; const LAS unsigned char* cidp = lds + P4_CID + 32 * tid;
        const int te = tlist[tile], c = te & 0xff, j = te >> 8, n = min(64, hist[c] - 64 * j);
        unsigned wv[8];
        { const v4u q0 = *(const LAS v4u*)(cidp), q1 = *(const LAS v4u*)(cidp + 16); wv[0] = q0.x; wv[1] = q0.y; wv[2] = q0.z; wv[3] = q0.w; wv[4] = q1.x; wv[5] = q1.y; wv[6] = q1.z; wv[7] = q1.w; }
        int cnt = 0;
#pragma unroll
        for (int i = 0; i < 32; ++i) cnt += (((wv[i >> 2] >> (8 * (i & 3))) & 0xffu) == (unsigned)c) ? 1 : 0;
        int inc = cnt;
#pragma unroll
        for (int o = 1; o < 64; o <<= 1) { const int v = __builtin_amdgcn_ds_bpermute((lane >= o ? lane - o : lane) << 2, inc); if (lane >= o) inc += v; }
        if (lane == 63) wsum[F.wave] = inc;
        LBAR();
        int base = inc - cnt;
        for (int ww = 0; ww < F.wave; ++ww) base += wsum[ww];
        if (tid < 64) { tok[tid] = -1; }
        LBAR();
#pragma unroll
        for (int i = 0; i < 32; ++i) if (((wv[i >> 2] >> (8 * (i & 3))) & 0xffu) == (unsigned)c) { if ((base >> 6) == j) tok[base & 63] = 32 * tid + i; ++base; }
        LBAR();
        if (tid < 64) { int tkn = tok[tid]; if (tkn < 0) { tkn = tok[0]; tok[tid] = tkn; } const f32x2 ww = *(const f32x2*)(RW + 2 * tkn); rwl[2 * tid] = ww.x; rwl[2 * tid + 1] = ww.y; }
        LBAR();
        PSTAMP(round == 0 ? 5 : 13);
        if (n > 32) p4_tile<4>(F, c, n, round == 0 ? 0 : 8); else p4_tile<2>(F, c, n, round == 0 ? 0 : 8);
        PSTAMP(round == 0 ? 10 : 18);
    }
}
struct Args { const float* in[18]; float* out; unsigned char* ws; int ph_lo, ph_hi; };
__global__ void __launch_bounds__(NTHR, 2) mk_fwd(Args args) {
    extern __shared__ __attribute__((aligned(16))) unsigned char lds[];
    Frame F;
    F.lds = (LAS unsigned char*)lds;
    F.tid = threadIdx.x; F.lane = F.tid & 63; F.wave = __builtin_amdgcn_readfirstlane(F.tid >> 6);
    F.G = gridDim.x; { const int bx = blockIdx.x; F.vcu = (F.G % 8 == 0) ? (bx % 8) * (F.G / 8) + bx / 8 : bx; }
    F.x = args.in[0]; F.c = args.in[1]; F.w_ada = args.in[2]; F.b_ada = args.in[3]; F.w_in = args.in[4]; F.conv_w = args.in[5]; F.w_out = args.in[6];
    F.ln1_g = args.in[7]; F.ln1_b = args.in[8]; F.wrg = args.in[9]; F.brg = args.in[10]; F.wre = args.in[11]; F.bre = args.in[12];
    F.wg = args.in[13]; F.wu = args.in[14]; F.wd = args.in[15]; F.ln2_g = args.in[16]; F.ln2_b = args.in[17];
    F.out = args.out; F.ws = args.ws; F.ctl = (gu32*)(args.ws + WS_CTL);
    volatile LAS unsigned* MISC = (volatile LAS unsigned*)(F.lds + MISC_OFF);
    if (F.tid < 64) MISC[F.tid] = 0u;
    __syncthreads();
    const int lo = args.ph_lo, hi = args.ph_hi;
    const bool multi = (hi - lo) > 1;
    XcdBarrier bar; bar.bar = (unsigned*)(F.ctl + CW_BAR); bar.x = 0; bar.st = nullptr;
    if (multi) bar = xcd_barrier_post((unsigned*)(F.ctl + CW_BAR), MISC + 8);
#ifndef MK_PH_MASK
#define MK_PH_MASK 15
#endif
#define IN(k) (((MK_PH_MASK >> (k)) & 1) && lo <= (k) && (k) < hi)
#define BOTH(k) (IN(k) && IN((k) + 1))
#define STAMP(i) PSTAMP(i)
    STAMP(0);
    if (IN(0)) { p0_prologue(F); if (BOTH(0)) xcd_barrier(bar); } STAMP(1);
    if (IN(1)) {
        pg8::Gemm g{(const pg8::bf16_t*)(F.ws + WS_HX), (const pg8::bf16_t*)(F.ws + WS_WIN), T, DPROJ, D}; pg8::StaticOrder S; S.init(T, DPROJ, F.G, (int)blockIdx.x);
        pg8::EpiProj E{(pg8::bf16_t*)(F.ws + WS_PROJ), DPROJ, DATT / 256, QSCALE};
        pg8::gemm_phase<pg8::EpiProj, pg8::StaticOrder, true, true>(F.lds, g, S, E);
        if (BOTH(1)) xcd_barrier(bar);
    } STAMP(2);
    if (IN(2)) {
        if (F.vcu < T / 64) p3_panel(F, F.vcu);
        if (BOTH(2)) xcd_barrier(bar);
    } STAMP(3);
    if (IN(3)) p4_moe(F);
    STAMP(11);
#ifdef MK_PROBE_LO
    xcd_barrier(bar); STAMP(12);
    if (blockIdx.x == 0 && threadIdx.x == 0) { volatile LAS unsigned* st = (volatile LAS unsigned*)(pstamp_lds); const unsigned dt = (st[MK_PROBE_HI] - st[MK_PROBE_LO]) * 4u; const unsigned long long t0 = __builtin_amdgcn_s_memrealtime();
        while (__builtin_amdgcn_s_memrealtime() - t0 < (unsigned long long)dt) __builtin_amdgcn_s_sleep(8); }
#endif
#undef IN
#undef BOTH
}

#if MK_STAGE < 4
template <class ALoad, class BLoad, class Epi>
__global__ void __launch_bounds__(256) k_sgemm(int M, int N, int K, ALoad al, BLoad bl, Epi ep) {
    __shared__ float As[16][65];
    __shared__ float Bs[16][65];
    const int tx = threadIdx.x & 15, ty = threadIdx.x >> 4;
    const int m0 = blockIdx.y * 64, n0 = blockIdx.x * 64;
    float acc[4][4] = {};
    for (int k0 = 0; k0 < K; k0 += 16) {
        for (int i = threadIdx.x; i < 64 * 16; i += 256) { const int mm = i >> 4, kk = i & 15; As[kk][mm] = al(m0 + mm, k0 + kk); }
        for (int i = threadIdx.x; i < 64 * 16; i += 256) { const int kk = i >> 6, nn = i & 63; Bs[kk][nn] = bl(k0 + kk, n0 + nn); }
        __syncthreads();
#pragma unroll
        for (int kk = 0; kk < 16; ++kk) {
            float a[4], b[4];
#pragma unroll
            for (int i = 0; i < 4; ++i) { a[i] = As[kk][ty * 4 + i]; b[i] = Bs[kk][tx * 4 + i]; }
#pragma unroll
            for (int i = 0; i < 4; ++i)
#pragma unroll
                for (int j = 0; j < 4; ++j) acc[i][j] += a[i] * b[j];
        }
        __syncthreads();
    }
#pragma unroll
    for (int i = 0; i < 4; ++i)
#pragma unroll
        for (int j = 0; j < 4; ++j) ep(m0 + ty * 4 + i, n0 + tx * 4 + j, acc[i][j]);
}

struct BLoadPlain { const float* w; int ldw; int pad; __device__ float operator()(int k, int n) const { return w[(size_t)k * ldw + n]; } };
struct EpiStore { float* c; int ldc; int pad; __device__ void operator()(int m, int n, float v) const { c[(size_t)m * ldc + n] = v; } };

struct ALoadMixF { const float* mix; __device__ float operator()(int m, int k) const { return mix[(size_t)m * D + k]; } };
__global__ void __launch_bounds__(64) k_attn_b(const bf16* __restrict__ proj, float* __restrict__ mixin) {
    const int gid = blockIdx.x * blockDim.x + threadIdx.x;
    const int t = gid % SEQ, h = (gid / SEQ) % NH, b = gid / (SEQ * NH);
    float q[HD], o[HD];
    const size_t rowq = ((size_t)(b * SEQ + t)) * DPROJ + h * HD;
#pragma unroll
    for (int d = 0; d < HD; ++d) { q[d] = bf2f(proj[rowq + d]); o[d] = 0.f; }
    float P = 1.f;
    for (int s = t - 1; s >= 0; --s) {
        const bf16* kr = proj + ((size_t)(b * SEQ + s)) * DPROJ + DATT + h * HD;
        const bf16* vr = proj + ((size_t)(b * SEQ + s)) * DPROJ + 2 * DATT + h * HD;
        float z = 0.f;
#pragma unroll
        for (int d = 0; d < HD; ++d) z += q[d] * bf2f(kr[d]);
        const float e = exp2f(z); const float r = 1.f / (1.f + e); const float a = (1.f - r) * P;
#pragma unroll
        for (int d = 0; d < HD; ++d) o[d] += a * bf2f(vr[d]);
        P *= r;
        if (P < 1e-30f) break;
    }
#pragma unroll
    for (int d = 0; d < HD; ++d) mixin[(size_t)(b * SEQ + t) * D + h * HD + d] = o[d];
}
__global__ void k_conv_b(const bf16* __restrict__ proj, const float* __restrict__ conv_w, float* __restrict__ mixin) {
    const int gid = blockIdx.x * blockDim.x + threadIdx.x;
    const int c = gid % DCONV, m = gid / DCONV, t = m % SEQ;
    float y = 0.f;
#pragma unroll
    for (int kk = 0; kk < 3; ++kk) { const int tt = t - 2 + kk; if (tt >= 0) { const size_t r = (size_t)(m - 2 + kk) * DPROJ; y += conv_w[kk * DCONV + c] * bf2f(proj[r + 2048 + c]) * bf2f(proj[r + 2560 + c]); } }
    mixin[(size_t)m * D + DATT + c] = bf2f(proj[(size_t)m * DPROJ + 1536 + c]) * y;
}
__global__ void __launch_bounds__(256) k_ln(float* io, const float* res, const float* __restrict__ ada, int gate_idx, const float* __restrict__ g, const float* __restrict__ beta) {
    __shared__ float red[256];
    const int m = blockIdx.x, b = m / SEQ, tid = threadIdx.x;
    float v[4]; float s = 0.f;
#pragma unroll
    for (int i = 0; i < 4; ++i) { const int d = tid + 256 * i; v[i] = ALPHA * res[(size_t)m * D + d] + ada[b * 6 * D + gate_idx * D + d] * io[(size_t)m * D + d]; s += v[i]; }
    red[tid] = s; __syncthreads();
    for (int o = 128; o > 0; o >>= 1) { if (tid < o) red[tid] += red[tid + o]; __syncthreads(); }
    const float mu = red[0] / D; __syncthreads();
    float s2 = 0.f;
#pragma unroll
    for (int i = 0; i < 4; ++i) { const float dd = v[i] - mu; s2 += dd * dd; }
    red[tid] = s2; __syncthreads();
    for (int o = 128; o > 0; o >>= 1) { if (tid < o) red[tid] += red[tid + o]; __syncthreads(); }
    const float rstd = 1.f / sqrtf(red[0] / D + LN_EPS);
#pragma unroll
    for (int i = 0; i < 4; ++i) { const int d = tid + 256 * i; io[(size_t)m * D + d] = (v[i] - mu) * rstd * g[d] + beta[d]; }
}

__global__ void __launch_bounds__(256) k_router(const float* __restrict__ x1, const float* __restrict__ ada, const float* __restrict__ wrg, const float* __restrict__ brg,
                                                const float* __restrict__ wre, const float* __restrict__ bre, int* __restrict__ r_e, float* __restrict__ r_w) {
    __shared__ float lg[4][36];
    const int m = blockIdx.x * 4 + (threadIdx.x >> 6), lane = threadIdx.x & 63, b = m / SEQ;
    float acc[36];
#pragma unroll
    for (int j = 0; j < 36; ++j) acc[j] = 0.f;
    for (int k = lane; k < D; k += 64) {
        const float hv = x1[(size_t)m * D + k] * (1.f + ada[b * 6 * D + 4 * D + k]) + ada[b * 6 * D + 3 * D + k];
#pragma unroll
        for (int j = 0; j < 4; ++j) acc[j] += hv * wrg[k * NG + j];
#pragma unroll
        for (int j = 0; j < 32; ++j) acc[4 + j] += hv * wre[k * NE + j];
    }
#pragma unroll
    for (int j = 0; j < 36; ++j) { float v = acc[j]; for (int o = 32; o > 0; o >>= 1) v += __shfl_xor(v, o); if (lane == 0) lg[threadIdx.x >> 6][j] = v; }
    if (lane == 0) {
        const float* L = lg[threadIdx.x >> 6];
        float gl[4]; int gi = 0;
        for (int j = 0; j < 4; ++j) gl[j] = L[j] + brg[j];
        float gm = gl[0]; for (int j = 1; j < 4; ++j) if (gl[j] > gm) { gm = gl[j]; gi = j; }
        float gs = 0.f; for (int j = 0; j < 4; ++j) gs += expf(gl[j] - gm);
        const float gprob = 1.f / gs;
        float el[8];
        for (int j = 0; j < 8; ++j) el[j] = L[4 + gi * 8 + j] + bre[gi * 8 + j];
        int i1 = 0; for (int j = 1; j < 8; ++j) if (el[j] > el[i1]) i1 = j;
        int i2 = (i1 == 0) ? 1 : 0; for (int j = 0; j < 8; ++j) if (j != i1 && el[j] > el[i2]) i2 = j;
        const float w1 = 1.f / (1.f + expf(el[i2] - el[i1])), w2 = 1.f - w1;
        r_e[m * 2 + 0] = gi * 8 + i1; r_e[m * 2 + 1] = gi * 8 + i2;
        r_w[m * 2 + 0] = w1 * gprob; r_w[m * 2 + 1] = w2 * gprob;
    }
}

__global__ void __launch_bounds__(256) k_moe_hid(const float* __restrict__ x1, const float* __restrict__ ada, const int* __restrict__ r_e,
                                                 const float* __restrict__ wg, const float* __restrict__ wu, float* __restrict__ hid) {
    __shared__ float hs[D];
    const int m = blockIdx.x, kk = blockIdx.y, f = threadIdx.x, b = m / SEQ;
    for (int k = threadIdx.x; k < D; k += 256) hs[k] = x1[(size_t)m * D + k] * (1.f + ada[b * 6 * D + 4 * D + k]) + ada[b * 6 * D + 3 * D + k];
    __syncthreads();
    const int e = r_e[m * 2 + kk];
    const float* g = wg + (size_t)e * D * DEXP + f; const float* u = wu + (size_t)e * D * DEXP + f;
    float ag = 0.f, au = 0.f;
    for (int k = 0; k < D; ++k) { ag += hs[k] * g[(size_t)k * DEXP]; au += hs[k] * u[(size_t)k * DEXP]; }
    hid[((size_t)m * 2 + kk) * DEXP + f] = ag / (1.f + expf(-ag)) * au;
}
__global__ void __launch_bounds__(256) k_moe_down(const float* __restrict__ hid, const int* __restrict__ r_e, const float* __restrict__ r_w,
                                                  const float* __restrict__ wd, float* __restrict__ y) {
    __shared__ float hs[2 * DEXP];
    const int m = blockIdx.x;
    for (int i = threadIdx.x; i < 2 * DEXP; i += 256) hs[i] = hid[(size_t)m * 2 * DEXP + i];
    __syncthreads();
    for (int d = threadIdx.x; d < D; d += 256) {
        float acc = 0.f;
        for (int kk = 0; kk < 2; ++kk) { const int e = r_e[m * 2 + kk]; const float* w = wd + (size_t)e * DEXP * D + d; float a = 0.f;
            for (int f = 0; f < DEXP; ++f) a += hs[kk * DEXP + f] * w[(size_t)f * D];
            acc += r_w[m * 2 + kk] * a; }
        y[(size_t)m * D + d] = acc;
    }
}
__global__ void k_copy(float* dst, const float* src, size_t n) { const size_t i = (size_t)blockIdx.x * 256 + threadIdx.x; if (i < n) dst[i] = src[i]; }


#endif
extern "C" void kernel_launch(void* const* d_in, const int* in_sizes, int n_in, void* d_out, int out_size, void* d_ws, size_t ws_size, hipStream_t stream) {
    static int grid = 0;
    if (grid == 0) {
        if (n_in != 18 || out_size != T * D || ws_size < WS_END) { fprintf(stderr, "kernel_launch: unexpected shapes (n_in %d, out %d, ws %zu)\n", n_in, out_size, ws_size); grid = -1; return; }
        int dev = 0, cus = 0, per_cu = 0;
        if (hipGetDevice(&dev) != hipSuccess || hipDeviceGetAttribute(&cus, hipDeviceAttributeMultiprocessorCount, dev) != hipSuccess) { grid = -1; return; }
        if (hipFuncSetAttribute((const void*)mk_fwd, hipFuncAttributeMaxDynamicSharedMemorySize, LDS_BYTES) != hipSuccess) { fprintf(stderr, "kernel_launch: hipFuncSetAttribute failed\n"); grid = -1; return; }
        if (hipOccupancyMaxActiveBlocksPerMultiprocessor(&per_cu, (const void*)mk_fwd, NTHR, LDS_BYTES) != hipSuccess || per_cu < 1) fprintf(stderr, "kernel_launch: occupancy query says %d blocks/CU\n", per_cu);
        (void)hipGetLastError();
        grid = cus;
    }
    if (grid < 0) return;
    (void)hipMemsetAsync((char*)d_ws + WS_CTL, 0, CTL_ZERO_BYTES, stream);
    Args a{};
    for (int i = 0; i < 18; ++i) a.in[i] = (const float*)d_in[i];
    a.out = (float*)d_out; a.ws = (unsigned char*)d_ws;
#if MK_STAGE == 4
    a.ph_lo = 0; a.ph_hi = 4;
    hipLaunchKernelGGL(mk_fwd, dim3(grid), dim3(NTHR), LDS_BYTES, stream, a);
#else
    const int nfast = MK_STAGE + 1;
#ifndef MK_REPEAT_PHASE
#define MK_REPEAT_PHASE -1
#endif
    for (int p = 0; p < nfast; ++p) { a.ph_lo = p; a.ph_hi = p + 1; hipLaunchKernelGGL(mk_fwd, dim3(grid), dim3(NTHR), LDS_BYTES, stream, a);
        if (p == MK_REPEAT_PHASE) hipLaunchKernelGGL(mk_fwd, dim3(grid), dim3(NTHR), LDS_BYTES, stream, a); }
    char* ws = (char*)d_ws; float* out = (float*)d_out;
    const float* x = (const float*)d_in[0];
    const float* ada = (const float*)(ws + WS_ADA);
    float* ybuf = (float*)(ws + WS_PROJ); float* hid = (float*)(ws + 160 * MiB);
    int* r_e = (int*)(ws + WS_RE); float* r_w = (float*)(ws + WS_RW);
#if MK_STAGE == 1
    float* mixin = (float*)(ws + 192 * MiB);
    k_conv_b<<<T * DCONV / 256, 256, 0, stream>>>((const bf16*)(ws + WS_PROJ), (const float*)d_in[5], mixin);
    k_attn_b<<<BATCH * NH * SEQ / 64, 64, 0, stream>>>((const bf16*)(ws + WS_PROJ), mixin);
    k_sgemm<<<dim3(D / 64, T / 64), 256, 0, stream>>>(T, D, D, ALoadMixF{mixin}, BLoadPlain{(const float*)d_in[6], D, 0}, EpiStore{out, D, 0});
    k_ln<<<T, 256, 0, stream>>>(out, x, ada, 2, (const float*)d_in[7], (const float*)d_in[8]);
    k_router<<<T / 4, 256, 0, stream>>>(out, ada, (const float*)d_in[9], (const float*)d_in[10], (const float*)d_in[11], (const float*)d_in[12], r_e, r_w);
#endif
#if MK_STAGE <= 2
    k_moe_hid<<<dim3(T, 2), 256, 0, stream>>>(out, ada, r_e, (const float*)d_in[13], (const float*)d_in[14], hid);
    k_moe_down<<<T, 256, 0, stream>>>(hid, r_e, r_w, (const float*)d_in[15], ybuf);
    k_ln<<<T, 256, 0, stream>>>(ybuf, out, ada, 5, (const float*)d_in[16], (const float*)d_in[17]);
    k_copy<<<(unsigned)(((size_t)T * D + 255) / 256), 256, 0, stream>>>(out, ybuf, (size_t)T * D);
#endif
#endif
}
```
